# Optimizing an MI355X kernel written in HIP

```python
import math
import jax
import jax.numpy as jnp
from jax import lax
import numpy as np

D_MODEL = 2048
BATCH = 2
SEQ = 4096
DEPTH = 4

N_MIXERS = 2
N_CONV_LAYERS = (DEPTH + 1) // 2
N_NSA_LAYERS = DEPTH // 2
CONV_WIDTH = 3
NSA_HEADS = 16
NSA_HEAD_DIM = 128
NSA_KV_GROUPS = 4
NSA_HPG = NSA_HEADS // NSA_KV_GROUPS
NSA_Q_COLS = NSA_HEADS * NSA_HEAD_DIM
NSA_KV_COLS = NSA_KV_GROUPS * NSA_HEAD_DIM
NSA_N_KV = 6
NSA_GATE_COLS = 3 * NSA_HEADS
NSA_IN_COLS = NSA_Q_COLS + NSA_N_KV * NSA_KV_COLS + NSA_GATE_COLS
CMP_BLOCK = 32
CMP_STRIDE = 16
CMP_HIDDEN = 256
SEL_BLOCK = 64
SEL_TOPK = 16
WINDOW = 512
Q_BLOCK = 128
FORCE_SCORE = 1e4
NEG_INF = -1e30
REL_BUCKETS = 32
REL_MAX_DIST = 128
PEER_HEADS = 8
PEER_NKEYS = 128
PEER_EXPERTS = PEER_NKEYS ** 2
PEER_DKEY = 256
PEER_TOPK = 16
PEER_CHUNK = 128
NORM_EPS = 1e-6

kernel_name = 'hybrid_shortconv_nsa_peer'


def rmsnorm(x, g):
    xf = x.astype(jnp.float32)
    y = xf * lax.rsqrt(jnp.mean(xf * xf, axis=-1, keepdims=True) + NORM_EPS)
    return (y * g.astype(jnp.float32)).astype(x.dtype)


def masked_softmax(logits, valid):
    z = jnp.where(valid, logits.astype(jnp.float32), NEG_INF)
    return jax.nn.softmax(z, axis=-1) * valid


def t5_bucket(dist):
    n = jnp.maximum(dist, 0)
    max_exact = REL_BUCKETS // 2
    nf = jnp.maximum(n, 1).astype(jnp.float32)
    large = max_exact + (jnp.log(nf / max_exact) / math.log(REL_MAX_DIST / max_exact)
                         * (REL_BUCKETS - max_exact)).astype(jnp.int32)
    large = jnp.minimum(large, REL_BUCKETS - 1)
    return jnp.where(n < max_exact, n, large)


def shortconv_mixer(h, w_in, conv_k, w_out):
    D = h.shape[-1]
    b_gate, c_gate, u = jnp.split(h @ w_in, 3, axis=-1)
    z = c_gate * u
    zc = lax.conv_general_dilated(z, conv_k[:, None, :], window_strides=(1,),
                                  padding=[(CONV_WIDTH - 1, 0)],
                                  dimension_numbers=('NWC', 'WIO', 'NWC'),
                                  feature_group_count=D)
    return (b_gate * zc) @ w_out


def compress_blocks(tok, blk_idx, pos, w1, w2):
    B, G, _, dh = tok.shape
    blocks = tok[:, :, blk_idx] + pos
    flat = blocks.reshape(B, G, blk_idx.shape[0], CMP_BLOCK * dh)
    return jax.nn.gelu(flat @ w1) @ w2


def nsa_mixer(h, w_in, cmp_pos_k, cmp_pos_v, cmp_w1_k, cmp_w2_k, cmp_w1_v, cmp_w2_v, w_out, rel_bias):
    B, S, _ = h.shape
    G, R, dh = NSA_KV_GROUPS, NSA_HPG, NSA_HEAD_DIM
    n_c = (S - CMP_BLOCK) // CMP_STRIDE + 1
    n_sel = S // SEL_BLOCK
    k_top = min(SEL_TOPK, n_sel)
    nq = S // Q_BLOCK
    scale = dh ** -0.5

    proj = h @ w_in
    q = proj[..., :NSA_Q_COLS].reshape(B, S, G, R, dh).transpose(0, 2, 3, 1, 4)
    kv = proj[..., NSA_Q_COLS:NSA_Q_COLS + NSA_N_KV * NSA_KV_COLS]
    kv = kv.reshape(B, S, NSA_N_KV, G, dh).transpose(2, 0, 3, 1, 4)
    k_cmp_tok, v_cmp_tok, k_sel, v_sel, k_win, v_win = kv[0], kv[1], kv[2], kv[3], kv[4], kv[5]
    gate_logits = proj[..., NSA_Q_COLS + NSA_N_KV * NSA_KV_COLS:].astype(jnp.float32)
    gates = jax.nn.sigmoid(gate_logits).reshape(B, S, 3, G, R).transpose(2, 0, 3, 4, 1)[..., None]

    blk_idx = jnp.arange(n_c)[:, None] * CMP_STRIDE + jnp.arange(CMP_BLOCK)[None]
    k_c = compress_blocks(k_cmp_tok, blk_idx, cmp_pos_k, cmp_w1_k, cmp_w2_k)
    v_c = compress_blocks(v_cmp_tok, blk_idx, cmp_pos_v, cmp_w1_v, cmp_w2_v)
    c_start = jnp.arange(n_c) * CMP_STRIDE
    c_end = c_start + CMP_BLOCK - 1
    j_sel = jnp.arange(n_sel)
    overlap = ((c_start[:, None] < (j_sel[None] + 1) * SEL_BLOCK)
               & (j_sel[None] * SEL_BLOCK <= c_end[:, None])).astype(jnp.float32)

    k_blocks = k_sel.reshape(B, G, n_sel, SEL_BLOCK, dh)
    v_blocks = v_sel.reshape(B, G, n_sel, SEL_BLOCK, dh)
    kw_pad = jnp.pad(k_win, ((0, 0), (0, 0), (WINDOW, 0), (0, 0)))
    vw_pad = jnp.pad(v_win, ((0, 0), (0, 0), (WINDOW, 0), (0, 0)))
    b_ix = jnp.arange(B)[:, None, None, None]
    g_ix = jnp.arange(G)[None, :, None, None]
    rb_heads = rel_bias.reshape(REL_BUCKETS, G, R)

    def head_bias(dist):
        return jnp.moveaxis(rb_heads[t5_bucket(dist)], (2, 3), (0, 1))

    def block(args):
        q_blk, i = args
        t = i * Q_BLOCK + jnp.arange(Q_BLOCK)
        dist_c = t[:, None] - c_end[None]
        lc = jnp.einsum('bgrqd,bgcd->bgrqc', q_blk, k_c) * scale + head_bias(dist_c)
        p_c = masked_softmax(lc, dist_c >= 0)
        o_c = jnp.einsum('bgrqc,bgcd->bgrqd', p_c.astype(v_c.dtype), v_c)
        imp = jnp.einsum('bgrqc,cj->bgqj', p_c, overlap)
        cur = t // SEL_BLOCK
        forced = (j_sel[None] == 0) | (j_sel[None] == cur[:, None]) | (j_sel[None] == cur[:, None] - 1)
        causal_j = j_sel[None] * SEL_BLOCK <= t[:, None]
        score = jnp.where(forced, FORCE_SCORE, jnp.where(causal_j, imp, -1.0))
        _, sel = lax.top_k(score, k_top)
        kg = k_blocks[b_ix, g_ix, sel]
        vg = v_blocks[b_ix, g_ix, sel]
        pos_s = sel[..., None] * SEL_BLOCK + jnp.arange(SEL_BLOCK)
        dist_s = t[:, None, None] - pos_s
        bias_s = jnp.moveaxis(rb_heads[t5_bucket(dist_s), g_ix[..., None]], -1, 2)
        ls = jnp.einsum('bgrqd,bgqkld->bgrqkl', q_blk, kg) * scale + bias_s
        p_s = masked_softmax(ls.reshape(B, G, R, Q_BLOCK, k_top * SEL_BLOCK),
                             (dist_s >= 0).reshape(B, G, 1, Q_BLOCK, k_top * SEL_BLOCK))
        p_s = p_s.reshape(B, G, R, Q_BLOCK, k_top, SEL_BLOCK)
        o_s = jnp.einsum('bgrqkl,bgqkld->bgrqd', p_s.astype(vg.dtype), vg)
        kw = lax.dynamic_slice_in_dim(kw_pad, i * Q_BLOCK, Q_BLOCK + WINDOW, axis=2)
        vw = lax.dynamic_slice_in_dim(vw_pad, i * Q_BLOCK, Q_BLOCK + WINDOW, axis=2)
        pos_w = i * Q_BLOCK - WINDOW + jnp.arange(Q_BLOCK + WINDOW)
        dist_w = t[:, None] - pos_w[None]
        valid_w = (dist_w >= 0) & (dist_w < WINDOW) & (pos_w[None] >= 0)
        lw = jnp.einsum('bgrqd,bgkd->bgrqk', q_blk, kw) * scale + head_bias(dist_w)
        p_w = masked_softmax(lw, valid_w)
        o_w = jnp.einsum('bgrqk,bgkd->bgrqd', p_w.astype(vw.dtype), vw)
        return o_c, o_s, o_w

    q_blocks = jnp.moveaxis(q.reshape(B, G, R, nq, Q_BLOCK, dh), 3, 0)
    o_c, o_s, o_w = lax.map(block, (q_blocks, jnp.arange(nq)))

    def unblock(o):
        return jnp.moveaxis(o, 0, 3).reshape(B, G, R, S, dh)

    o = gates[0] * unblock(o_c) + gates[1] * unblock(o_s) + gates[2] * unblock(o_w)
    o = o.transpose(0, 3, 1, 2, 4).reshape(B, S, NSA_Q_COLS).astype(h.dtype)
    return o @ w_out


def peer_ffn(h, w_q, sub_keys, u_emb, v_emb):
    B, S, D = h.shape
    T = B * S
    xt = h.reshape(T, D)
    q = (xt @ w_q).reshape(T, PEER_HEADS, 2, PEER_DKEY // 2)
    s = jnp.einsum('thpd,hpnd->thpn', q, sub_keys).astype(jnp.float32)
    s1, i1 = lax.top_k(s[:, :, 0], PEER_TOPK)
    s2, i2 = lax.top_k(s[:, :, 1], PEER_TOPK)
    cand = (s1[..., :, None] + s2[..., None, :]).reshape(T, PEER_HEADS, PEER_TOPK * PEER_TOPK)
    cand_idx = (i1[..., :, None] * PEER_NKEYS + i2[..., None, :]).reshape(T, PEER_HEADS, PEER_TOPK * PEER_TOPK)
    top_s, top_pos = lax.top_k(cand, PEER_TOPK)
    idx = jnp.take_along_axis(cand_idx, top_pos, axis=-1).reshape(T, PEER_HEADS * PEER_TOPK)
    gate = jax.nn.softmax(top_s, axis=-1).reshape(T, PEER_HEADS * PEER_TOPK).astype(h.dtype)
    n_chunk = T // PEER_CHUNK

    def chunk(args):
        x_c, idx_c, g_c = args
        act = jax.nn.gelu(jnp.einsum('ckd,cd->ck', u_emb[idx_c], x_c))
        return jnp.einsum('ck,ckd->cd', g_c * act, v_emb[idx_c])

    out = lax.map(chunk, (xt.reshape(n_chunk, PEER_CHUNK, D),
                          idx.reshape(n_chunk, PEER_CHUNK, -1),
                          gate.reshape(n_chunk, PEER_CHUNK, -1)))
    return out.reshape(B, S, D)


def setup_inputs(seed: int = 0) -> dict:
    key = jax.random.key(seed)
    ks = jax.random.split(key, 22)
    D = D_MODEL
    dh = NSA_HEAD_DIM

    def nrm(k, shape, scale):
        return jax.random.normal(k, shape, jnp.float32) * scale

    return {
        'x': nrm(ks[0], (BATCH, SEQ, D), 1.0),
        'rel_bias': nrm(ks[1], (REL_BUCKETS, NSA_HEADS), 0.5),
        'mix_norm': 1.0 + nrm(ks[2], (DEPTH, D), 0.01),
        'ffn_norm': 1.0 + nrm(ks[3], (DEPTH, D), 0.01),
        'final_norm': 1.0 + nrm(ks[4], (D,), 0.01),
        'conv_w_in': nrm(ks[5], (N_CONV_LAYERS, D, 3 * D), D ** -0.5),
        'conv_kernel': nrm(ks[6], (N_CONV_LAYERS, CONV_WIDTH, D), CONV_WIDTH ** -0.5),
        'conv_w_out': nrm(ks[7], (N_CONV_LAYERS, D, D), D ** -0.5),
        'nsa_w_in': nrm(ks[8], (N_NSA_LAYERS, D, NSA_IN_COLS), D ** -0.5),
        'nsa_cmp_pos_k': nrm(ks[9], (N_NSA_LAYERS, CMP_BLOCK, dh), 0.02),
        'nsa_cmp_pos_v': nrm(ks[10], (N_NSA_LAYERS, CMP_BLOCK, dh), 0.02),
        'nsa_cmp_w1_k': nrm(ks[11], (N_NSA_LAYERS, CMP_BLOCK * dh, CMP_HIDDEN), (CMP_BLOCK * dh) ** -0.5),
        'nsa_cmp_w2_k': nrm(ks[12], (N_NSA_LAYERS, CMP_HIDDEN, dh), CMP_HIDDEN ** -0.5),
        'nsa_cmp_w1_v': nrm(ks[13], (N_NSA_LAYERS, CMP_BLOCK * dh, CMP_HIDDEN), (CMP_BLOCK * dh) ** -0.5),
        'nsa_cmp_w2_v': nrm(ks[14], (N_NSA_LAYERS, CMP_HIDDEN, dh), CMP_HIDDEN ** -0.5),
        'nsa_w_out': nrm(ks[15], (N_NSA_LAYERS, NSA_Q_COLS, D), NSA_Q_COLS ** -0.5),
        'peer_w_q': nrm(ks[16], (DEPTH, D, PEER_HEADS * PEER_DKEY), D ** -0.5),
        'peer_sub_keys': nrm(ks[17], (DEPTH, PEER_HEADS, 2, PEER_NKEYS, PEER_DKEY // 2), (PEER_DKEY // 2) ** -0.5),
        'peer_u': nrm(ks[18], (DEPTH, PEER_EXPERTS, D), D ** -0.5),
        'peer_v': nrm(ks[19], (DEPTH, PEER_EXPERTS, D), (PEER_HEADS * PEER_TOPK) ** -0.5),
    }


def reference(x, rel_bias, mix_norm, ffn_norm, final_norm, conv_w_in, conv_kernel, conv_w_out,
              nsa_w_in, nsa_cmp_pos_k, nsa_cmp_pos_v, nsa_cmp_w1_k, nsa_cmp_w2_k, nsa_cmp_w1_v,
              nsa_cmp_w2_v, nsa_w_out, peer_w_q, peer_sub_keys, peer_u, peer_v):
    h = x
    for i in range(DEPTH):
        hn = rmsnorm(h, mix_norm[i])
        j = i // N_MIXERS
        if i % N_MIXERS == 0:
            h = h + shortconv_mixer(hn, conv_w_in[j], conv_kernel[j], conv_w_out[j])
        else:
            h = h + nsa_mixer(hn, nsa_w_in[j], nsa_cmp_pos_k[j], nsa_cmp_pos_v[j],
                              nsa_cmp_w1_k[j], nsa_cmp_w2_k[j], nsa_cmp_w1_v[j], nsa_cmp_w2_v[j],
                              nsa_w_out[j], rel_bias)
        h = h + peer_ffn(rmsnorm(h, ffn_norm[i]), peer_w_q[i], peer_sub_keys[i], peer_u[i], peer_v[i])
    return rmsnorm(h, final_norm)
```

```cpp
#include <hip/hip_runtime.h>
#include <cstdio>
#include <cstdint>

#ifndef MK_N_LAUNCHES
#define MK_N_LAUNCHES 1
#endif

#ifndef PROBE_MASK
#define PROBE_MASK 0
#endif
#ifndef PROBE_TSKIP
#define PROBE_TSKIP 0
#endif
#define PROBE_U ((PROBE_MASK >> 14) & 1)
#define PROBE_V ((PROBE_MASK >> 15) & 1)
#define PROBE_UF ((PROBE_MASK >> 16) & 1)
#define PROBE_VF ((PROBE_MASK >> 17) & 1)
#define PROBE_UC ((PROBE_MASK >> 18) & 1)
#define LAS __attribute__((address_space(3)))
#define GAS __attribute__((address_space(1)))
typedef unsigned short bf16_t;
typedef short bf16x8 __attribute__((ext_vector_type(8)));
typedef short s16x4 __attribute__((ext_vector_type(4)));
typedef short v4i16_t __attribute__((ext_vector_type(4)));
typedef float f32x2 __attribute__((ext_vector_type(2)));
typedef _Float16 h16x2 __attribute__((ext_vector_type(2)));
typedef float f32x4 __attribute__((ext_vector_type(4)));
typedef float f32x16 __attribute__((ext_vector_type(16)));
typedef unsigned u32x2 __attribute__((ext_vector_type(2)));
typedef unsigned u32x4 __attribute__((ext_vector_type(4)));
typedef __bf16 bf16x2_t __attribute__((ext_vector_type(2)));
typedef GAS unsigned gu32;

constexpr int DM = 2048, SEQ = 4096, NB = 2, T = NB * SEQ, DEPTH = 4;
constexpr int NCIN = 6144, NNIN = 5168, NNPAD = 5376;
constexpr int NEXP = 16384, EROW = 1024, CONV_SPLIT = 11520  ;
constexpr float EPS = 1e-6f;
constexpr float LOG2E = 1.4426950408889634f;
constexpr float QSCALE = 0.08838834764831845f * LOG2E;

constexpr size_t MiB = 1u << 20;
constexpr size_t WS_CTL = 0, CTL_ZERO_BYTES = 1 * MiB;
constexpr size_t WS_SSQ = 1 * MiB;
constexpr size_t WS_GATES = 2 * MiB;
constexpr size_t WS_BIAS1P = 4 * MiB;
constexpr size_t WS_KC = 5 * MiB;
constexpr size_t WS_VC = 5 * MiB + 512 * 1024;
constexpr size_t WS_KEYSPAD = 6 * MiB;
constexpr size_t WS_WCIN = 16 * MiB;
constexpr size_t WS_WCOUT = 64 * MiB;
constexpr size_t WS_WNIN = 80 * MiB;
constexpr size_t WS_WNOUT = 122 * MiB;
constexpr size_t WS_WQN = 138 * MiB;
constexpr size_t WS_WPT = 170 * MiB;
constexpr size_t WS_WC1 = 202 * MiB;
constexpr size_t WS_H = 256 * MiB;
constexpr size_t WS_HB = 320 * MiB;
constexpr size_t WS_BG = 352 * MiB;
constexpr size_t WS_Z = 384 * MiB;
constexpr size_t WS_Y = 416 * MiB;
constexpr size_t WS_KV = 384 * MiB;
constexpr size_t WS_O = 448 * MiB;
constexpr size_t WS_SC = 480 * MiB;
constexpr size_t WS_SLAB = 544 * MiB;
constexpr size_t WS_UB = 640 * MiB;
constexpr size_t WS_VB = 768 * MiB;
constexpr size_t WS_USC = 896 * MiB;
constexpr size_t WS_VSC = 897 * MiB;
constexpr size_t WS_END = 898 * MiB;

constexpr int RING_BYTES = 155648;
constexpr int RS_OFF = RING_BYTES;
constexpr int MISC_OFF = RS_OFF + 4096;
constexpr int LDS_BYTES = 163840;
static_assert(MISC_OFF + 128 <= LDS_BYTES, "LDS map");

#define LDS_WAIT() asm volatile("s_waitcnt lgkmcnt(0)" ::: "memory")
#define VM_WAIT() asm volatile("s_waitcnt vmcnt(0)" ::: "memory")
#define RLX_AGENT __ATOMIC_RELAXED, __HIP_MEMORY_SCOPE_AGENT

__device__ __forceinline__ unsigned cvtpk(float lo, float hi) { f32x2 v = {lo, hi}; bf16x2_t b = __builtin_convertvector(v, bf16x2_t); return __builtin_bit_cast(unsigned, b); }
__device__ __forceinline__ float bf_lo(unsigned p) { return __uint_as_float(p << 16); }
__device__ __forceinline__ float bf_hi(unsigned p) { return __uint_as_float(p & 0xffff0000u); }
__device__ __forceinline__ float wave_sum(float v) {
#pragma unroll
    for (int o = 1; o < 64; o <<= 1) v += __shfl_xor(v, o);
    return v;
}
template <int CTRL> __device__ __forceinline__ float dpp_f(float x) { return __builtin_bit_cast(float, __builtin_amdgcn_update_dpp(0, __builtin_bit_cast(int, x), CTRL, 0xF, 0xF, true)); }
__device__ __forceinline__ float row_sum16(float x) { x += dpp_f<0xB1>(x); x += dpp_f<0x4E>(x); x += dpp_f<0x141>(x); x += dpp_f<0x140>(x); return x; }
__device__ __forceinline__ float rows_total(float x) {
    const float a = __builtin_bit_cast(float, __builtin_amdgcn_readlane(__builtin_bit_cast(int, x), 0)), b = __builtin_bit_cast(float, __builtin_amdgcn_readlane(__builtin_bit_cast(int, x), 16));
    const float c = __builtin_bit_cast(float, __builtin_amdgcn_readlane(__builtin_bit_cast(int, x), 32)), d = __builtin_bit_cast(float, __builtin_amdgcn_readlane(__builtin_bit_cast(int, x), 48));
    return (a + b) + (c + d);
}
__device__ __forceinline__ float gelu_tanh(float x) {
    const float y = 0.7978845608028654f * (x + 0.044715f * x * x * x);
    const float e = __builtin_amdgcn_exp2f(y * (2.0f * LOG2E));
    const float th = 1.0f - 2.0f * __builtin_amdgcn_rcpf(e + 1.0f);
    return 0.5f * x * (1.0f + th);
}
__device__ __forceinline__ float dot2(unsigned a, unsigned b, float acc) { return __builtin_amdgcn_fdot2_f32_bf16(__builtin_bit_cast(bf16x2_t, a), __builtin_bit_cast(bf16x2_t, b), acc, false); }

__device__ __forceinline__ int fresh_lane() { unsigned z = 0u; asm volatile("v_mov_b32 %0, 0" : "=v"(z)); return (int)__builtin_amdgcn_mbcnt_hi(~0u, __builtin_amdgcn_mbcnt_lo(~0u, z)); }
namespace pg8 {
constexpr int BM = 256, BK = 64, HALF = 128, HTB = HALF * BK * 2, STAGE_BYTES = 8 * HTB, NXCD = 8, WGM = 8;
__host__ __device__ __forceinline__ int lds_byte(int r, int c) { const int st = (r >> 4) * 2 + (c >> 5), rr = r & 15, cc = c & 31, ob = rr * 64 + cc * 2; return st * 1024 + (ob ^ (((ob >> 9) & 1) << 5)); }
__host__ __device__ __forceinline__ void stage_rc(int b, int& R, int& C) { const int st = b / 1024, sb = b % 1024, swz = sb ^ (((sb >> 9) & 1) << 5); R = (st >> 1) * 16 + swz / 64; C = (st & 1) * 32 + (swz % 64) / 2; }
__host__ __device__ __forceinline__ int perm32(int rho) { const int n = rho >> 4, i = rho & 15; return 8 * (i >> 2) + 4 * n + (i & 3); }

struct Unit { int pm, pn, ord; };
struct Gemm { int lda, ldb, K; };

struct PlainOrder {
    const char* A; const char* B; size_t tsA, tsB; int nM, nN, nwg, G, c;
    __device__ void init(const void* A_, int lda, const void* B_, int ldb, int M, int N, int G_, int c_) { A = (const char*)A_; B = (const char*)B_; tsA = (size_t)BM * lda * 2; tsB = (size_t)BM * ldb * 2; nM = M / BM; nN = N / BM; nwg = nM * nN; G = G_; c = c_; }
    __device__ bool next(int i, Unit& u) const {
        const long L = (long)i * G + c; if (L >= nwg) return false;
        int wgid = (int)L; { const int q = nwg / NXCD, r = nwg % NXCD, xcd = wgid % NXCD, off = wgid / NXCD; wgid = (xcd < r ? xcd * (q + 1) : r * (q + 1) + (xcd - r) * q) + off; }
        const int nig = WGM * nN, gid = wgid / nig, fm = gid * WGM, gsz = (nM - fm) < WGM ? (nM - fm) : WGM;
        u.pm = fm + ((wgid % nig) % gsz); u.pn = (wgid % nig) / gsz; u.ord = i; return true;
    }
    __device__ __forceinline__ const char* a_ptr(const Unit& u) const { return A + (size_t)u.pm * tsA; }
    __device__ __forceinline__ const char* b_ptr(const Unit& u) const { return B + (size_t)u.pn * tsB; }
};
struct FoldOrder {
    const char* A; const char* B; int G, c;
    __device__ bool next(int i, Unit& u) const { const int L = i * G + c; if (L >= 256) return false; u.pm = L >> 3; u.pn = L & 7; u.ord = i; return true; }
    __device__ __forceinline__ const char* a_ptr(const Unit& u) const { return A + (size_t)u.pm * 256 * 256 * 2; }
    __device__ __forceinline__ const char* b_ptr(const Unit& u) const { return B + (size_t)(u.pm >> 3) * 2048 * 2048 * 2 + (size_t)u.pn * 256 * 2048 * 2 + (size_t)(u.pm & 7) * 256 * 2; }
};
struct CmpOrder {
    const char* KV; const char* W; int G, c;
    __device__ bool next(int i, Unit& u) const { const int L = i * G + c; if (L >= 128) return false; u.pm = L; u.pn = 0; u.ord = i; return true; }
    __device__ __forceinline__ const char* a_ptr(const Unit& u) const { const int kv = u.pm >> 6, grp = (u.pm >> 3) & 7, ks = u.pm & 7; return KV + ((size_t)(kv * 8 + grp) * 4096 * 128 + (size_t)ks * 512) * 2; }
    __device__ __forceinline__ const char* b_ptr(const Unit& u) const { const int kv = u.pm >> 6, ks = u.pm & 7; return W + ((size_t)kv * 256 * 4096 + (size_t)ks * 512) * 2; }
};

typedef f32x4 Acc[2][2][4][2];

struct EpiConvIn {
    static constexpr bool PERM = true;
    bf16_t* Bg; bf16_t* Z; const LAS float* rs;
    __device__ __forceinline__ void operator()(const Acc& acc, const Unit& u, int wr, int wc, int fr, int fq) const {
#pragma unroll
        for (int ai = 0; ai < 2; ++ai)
#pragma unroll
            for (int m = 0; m < 4; ++m) {
                const int lr = ai * HALF + wr * 64 + m * 16 + fr; const float r = rs[u.ord * 256 + lr]; const size_t grow = (size_t)u.pm * BM + lr;
                if (u.pn < 8) {
#pragma unroll
                    for (int bj = 0; bj < 2; ++bj) { const f32x4 v0 = acc[ai][bj][m][0] * r, v1 = acc[ai][bj][m][1] * r;
                        u32x4 w; w.x = cvtpk(v0[0], v0[1]); w.y = cvtpk(v0[2], v0[3]); w.z = cvtpk(v1[0], v1[1]); w.w = cvtpk(v1[2], v1[3]);
                        *(u32x4*)(Bg + grow * DM + u.pn * 256 + bj * HALF + wc * 32 + 8 * fq) = w; }
                } else {
                    const float r2 = r * r;
                    const f32x4 v0 = acc[ai][0][m][0] * acc[ai][1][m][0] * r2, v1 = acc[ai][0][m][1] * acc[ai][1][m][1] * r2;
                    u32x4 w; w.x = cvtpk(v0[0], v0[1]); w.y = cvtpk(v0[2], v0[3]); w.z = cvtpk(v1[0], v1[1]); w.w = cvtpk(v1[2], v1[3]);
                    *(u32x4*)(Z + grow * DM + (u.pn - 8) * 128 + wc * 32 + 8 * fq) = w;
                }
            }
    }
};
struct EpiResid {
    static constexpr bool PERM = false;
    const float* base; float* H; bf16_t* Hb; float* ssq;
    __device__ __forceinline__ void operator()(const Acc& acc, const Unit& u, int wr, int wc, int fr, int fq) const {
#pragma unroll
        for (int ai = 0; ai < 2; ++ai)
#pragma unroll
            for (int m = 0; m < 4; ++m) {
                const int lr = ai * HALF + wr * 64 + m * 16 + fr; const size_t grow = (size_t)u.pm * BM + lr; const size_t off = grow * DM + u.pn * 256 + wc * 32 + 4 * fq;
                float s = 0.f;
#pragma unroll
                for (int bj = 0; bj < 2; ++bj)
#pragma unroll
                    for (int n = 0; n < 2; ++n) { const f32x4 b = *(const f32x4*)(base + off + bj * HALF + n * 16); const f32x4 o = b + acc[ai][bj][m][n];
                        *(f32x4*)(H + off + bj * HALF + n * 16) = o; s += (o[0] * o[0] + o[1] * o[1]) + (o[2] * o[2] + o[3] * o[3]);
                        u32x2 w; w.x = cvtpk(o[0], o[1]); w.y = cvtpk(o[2], o[3]); *(u32x2*)(Hb + off + bj * HALF + n * 16) = w; }
                s += __shfl_xor(s, 16); s += __shfl_xor(s, 32);
                if (fq == 0) ssq[grow * 32 + u.pn * 4 + wc] = s;
            }
    }
};
struct EpiNsaIn {
    static constexpr bool PERM = true;
    bf16_t* Q; bf16_t* KV; float* gates; const LAS float* rs;
    __device__ __forceinline__ void operator()(const Acc& acc, const Unit& u, int wr, int wc, int fr, int fq) const {
#pragma unroll
        for (int ai = 0; ai < 2; ++ai)
#pragma unroll
            for (int m = 0; m < 4; ++m) {
                const int lr = ai * HALF + wr * 64 + m * 16 + fr; const float r = rs[u.ord * 256 + lr]; const size_t grow = (size_t)u.pm * BM + lr;
                if (u.pn < 8) {
                    const float rq = r * QSCALE;
#pragma unroll
                    for (int bj = 0; bj < 2; ++bj) { const f32x4 v0 = acc[ai][bj][m][0] * rq, v1 = acc[ai][bj][m][1] * rq;
                        u32x4 w; w.x = cvtpk(v0[0], v0[1]); w.y = cvtpk(v0[2], v0[3]); w.z = cvtpk(v1[0], v1[1]); w.w = cvtpk(v1[2], v1[3]);
                        *(u32x4*)(Q + grow * DM + u.pn * 256 + bj * HALF + wc * 32 + 8 * fq) = w; }
                } else if (u.pn < 20) {
                    const int nn = (u.pn - 8) >> 1, b = (int)(grow >> 12), s = (int)(grow & 4095);
#pragma unroll
                    for (int bj = 0; bj < 2; ++bj) { const int g = ((u.pn - 8) & 1) * 2 + bj; const f32x4 v0 = acc[ai][bj][m][0] * r, v1 = acc[ai][bj][m][1] * r;
                        u32x4 w; w.x = cvtpk(v0[0], v0[1]); w.y = cvtpk(v0[2], v0[3]); w.z = cvtpk(v1[0], v1[1]); w.w = cvtpk(v1[2], v1[3]);
                        *(u32x4*)(KV + ((size_t)((nn * 2 + b) * 4 + g) * 4096 + s) * 128 + wc * 32 + 8 * fq) = w; }
                } else {
                    const int col = wc * 32 + 8 * fq;
                    if (col < 48) {
                        f32x4 v0 = acc[ai][0][m][0] * r, v1 = acc[ai][0][m][1] * r;
#pragma unroll
                        for (int j = 0; j < 4; ++j) { v0[j] = __builtin_amdgcn_rcpf(1.0f + __builtin_amdgcn_exp2f(-v0[j] * LOG2E)); v1[j] = __builtin_amdgcn_rcpf(1.0f + __builtin_amdgcn_exp2f(-v1[j] * LOG2E)); }
                        *(f32x4*)(gates + grow * 48 + col) = v0; *(f32x4*)(gates + grow * 48 + col + 4) = v1;
                    }
                }
            }
    }
};
struct EpiScores {
    static constexpr bool PERM = true;
    bf16_t* S; const LAS float* rs;
    __device__ __forceinline__ void operator()(const Acc& acc, const Unit& u, int wr, int wc, int fr, int fq) const {
#pragma unroll
        for (int ai = 0; ai < 2; ++ai)
#pragma unroll
            for (int m = 0; m < 4; ++m) {
                const int lr = ai * HALF + wr * 64 + m * 16 + fr; const float r = rs[u.ord * 256 + lr]; bf16_t* rowp = S + ((size_t)u.pm * BM + lr) * DM + u.pn * 256 + wc * 32 + 8 * fq;
#pragma unroll
                for (int bj = 0; bj < 2; ++bj) { const f32x4 v0 = acc[ai][bj][m][0] * r, v1 = acc[ai][bj][m][1] * r;
                    u32x4 w; w.x = cvtpk(v0[0], v0[1]); w.y = cvtpk(v0[2], v0[3]); w.z = cvtpk(v1[0], v1[1]); w.w = cvtpk(v1[2], v1[3]);
                    *(u32x4*)(rowp + bj * HALF) = w; }
            }
    }
};
struct EpiSlab {
    static constexpr bool PERM = true;
    bf16_t* slab;
    __device__ __forceinline__ void operator()(const Acc& acc, const Unit& u, int wr, int wc, int fr, int fq) const {
        const int kv = u.pm >> 6, grp = (u.pm >> 3) & 7, ks = u.pm & 7;
        bf16_t* base = slab + ((size_t)(ks * 2 + kv) * 2048 + grp * 256) * 256;
#pragma unroll
        for (int ai = 0; ai < 2; ++ai)
#pragma unroll
            for (int m = 0; m < 4; ++m) {
                const int lr = ai * HALF + wr * 64 + m * 16 + fr; bf16_t* rowp = base + (size_t)lr * 256 + wc * 32 + 8 * fq;
#pragma unroll
                for (int bj = 0; bj < 2; ++bj) { const f32x4 v0 = acc[ai][bj][m][0], v1 = acc[ai][bj][m][1];
                    u32x4 w; w.x = cvtpk(v0[0], v0[1]); w.y = cvtpk(v0[2], v0[3]); w.z = cvtpk(v1[0], v1[1]); w.w = cvtpk(v1[2], v1[3]);
                    *(u32x4*)(rowp + bj * HALF) = w; }
            }
    }
};
struct EpiBf16 {
    static constexpr bool PERM = true;
    bf16_t* O; int ldc;
    __device__ __forceinline__ void operator()(const Acc& acc, const Unit& u, int wr, int wc, int fr, int fq) const {
#pragma unroll
        for (int ai = 0; ai < 2; ++ai)
#pragma unroll
            for (int m = 0; m < 4; ++m) {
                const int lr = ai * HALF + wr * 64 + m * 16 + fr; bf16_t* rowp = O + ((size_t)u.pm * BM + lr) * ldc + u.pn * 256 + wc * 32 + 8 * fq;
#pragma unroll
                for (int bj = 0; bj < 2; ++bj) { const f32x4 v0 = acc[ai][bj][m][0], v1 = acc[ai][bj][m][1];
                    u32x4 w; w.x = cvtpk(v0[0], v0[1]); w.y = cvtpk(v0[2], v0[3]); w.z = cvtpk(v1[0], v1[1]); w.w = cvtpk(v1[2], v1[3]);
                    *(u32x4*)(rowp + bj * HALF) = w; }
            }
    }
};

template <int LDA, int LDB, int KLEN, class Epi, class Sched>
__device__ __forceinline__ void gemm_phase(LAS unsigned char* lds, int tid, const Sched& S, const Epi& E) {
    constexpr Gemm g{LDA, LDB, KLEN};
    const int wid = __builtin_amdgcn_readfirstlane(tid >> 6), lane = tid & 63, wr = wid >> 2, wc = wid & 3, fr = lane & 15, fq = lane >> 4;
    const int nt = g.K / BK;
    unsigned voffA[2], voffB[2];
#pragma unroll
    for (int i = 0; i < 2; ++i) { int R, C; stage_rc(tid * 16 + i * 8192, R, C); const int Rb = Epi::PERM ? ((R & ~31) + perm32(R & 31)) : R;
        voffA[i] = (unsigned)(R * g.lda + C) * 2u; voffB[i] = (unsigned)(Rb * g.ldb + C) * 2u; }
    const size_t kstep = (size_t)(BK * 2);
    const size_t hstepA = (size_t)HALF * g.lda * 2, hstepB = (size_t)HALF * g.ldb * 2;
    const unsigned ldsw = (unsigned)wid * 1024u;
    const int aoff = lds_byte(wr * 64 + fr, fq * 8), boff = lds_byte(wc * 32 + fr, fq * 8);
#define PG8_SA(b, h) (((b) * 2 + (h)) * HTB)
#define PG8_SB(b, h) ((4 + (b) * 2 + (h)) * HTB)
#define PG8_STAGE(bufoff, gbase, voff) do { _Pragma("unroll") for (int _i = 0; _i < 2; ++_i) \
        __builtin_amdgcn_global_load_lds((const unsigned*)((const char*)(gbase) + (voff)[_i]), (LAS unsigned*)(lds + (bufoff) + ldsw + _i * 8192), 16, 0, 0); } while (0)
#define PG8_LDA(dst, b, h) do { _Pragma("unroll") for (int m = 0; m < 4; ++m) _Pragma("unroll") for (int k = 0; k < 2; ++k) dst[m][k] = *(const LAS bf16x8*)(lds + PG8_SA(b, h) + aoff + m * 2048 + k * 1024); } while (0)
#define PG8_LDB(dst, b, h) do { _Pragma("unroll") for (int n = 0; n < 2; ++n) _Pragma("unroll") for (int k = 0; k < 2; ++k) dst[n][k] = *(const LAS bf16x8*)(lds + PG8_SB(b, h) + boff + n * 2048 + k * 1024); } while (0)
#define PG8_MMA(ai, bj, At, Bt) do { __builtin_amdgcn_s_setprio(1); _Pragma("unroll") for (int m = 0; m < 4; ++m) _Pragma("unroll") for (int n = 0; n < 2; ++n) _Pragma("unroll") for (int k = 0; k < 2; ++k) \
        acc[ai][bj][m][n] = __builtin_amdgcn_mfma_f32_16x16x32_bf16(Bt[n][k], At[m][k], acc[ai][bj][m][n], 0, 0, 0); __builtin_amdgcn_s_setprio(0); } while (0)
#define PG8_WAIT_V(n) asm volatile("s_waitcnt vmcnt(" #n ")" ::: "memory")
#define PG8_WAIT_L(n) asm volatile("s_waitcnt lgkmcnt(" #n ")" ::: "memory")
#define PG8_BAR __builtin_amdgcn_s_barrier()
#define PG8_SCHED __builtin_amdgcn_sched_barrier(0)
    Unit cur, nxt; int ui = 0;
    if (!S.next(0, cur)) return;
    Acc acc;
#pragma unroll
    for (int a = 0; a < 2; ++a)
#pragma unroll
        for (int b = 0; b < 2; ++b)
#pragma unroll
            for (int m = 0; m < 4; ++m)
#pragma unroll
                for (int n = 0; n < 2; ++n) acc[a][b][m][n] = (f32x4){0.f, 0.f, 0.f, 0.f};
    bf16x8 At[4][2], B0[2][2], B1[2][2];
    const char* cA = S.a_ptr(cur); const char* cB = S.b_ptr(cur);
    asm volatile("" : "+s"(cA), "+s"(cB));
    PG8_STAGE(PG8_SB(0, 0), cB, voffB); PG8_STAGE(PG8_SB(0, 1), cB + hstepB, voffB); PG8_STAGE(PG8_SA(0, 0), cA, voffA); PG8_STAGE(PG8_SA(0, 1), cA + hstepA, voffA);
    if (wr == 1) PG8_BAR;
    PG8_WAIT_V(2); PG8_BAR;
    PG8_STAGE(PG8_SB(1, 0), cB + kstep, voffB); PG8_STAGE(PG8_SA(1, 0), cA + kstep, voffA); PG8_STAGE(PG8_SB(1, 1), cB + hstepB + kstep, voffB);
    PG8_WAIT_V(6); PG8_BAR;
    for (;;) {
        const bool has_next = S.next(ui + 1, nxt);
        const char* nA = has_next ? S.a_ptr(nxt) : cA; const char* nB = has_next ? S.b_ptr(nxt) : cB;
        asm volatile("" : "+s"(nA), "+s"(nB));
        for (int t = 0; t < nt; t += 2) {
            const bool last = (t == nt - 2);
            const char* a1 = cA + (size_t)(t + 1) * kstep;
            const char* a2 = last ? nA : cA + (size_t)(t + 2) * kstep; const char* b2 = last ? nB : cB + (size_t)(t + 2) * kstep;
            const char* a3 = a2 + kstep; const char* b3 = b2 + kstep;
            asm volatile("" : "+s"(a1), "+s"(a2), "+s"(b2), "+s"(a3), "+s"(b3));
            PG8_LDB(B0, 0, 0); PG8_LDB(B1, 0, 1); PG8_SCHED; PG8_LDA(At, 0, 0); PG8_STAGE(PG8_SA(1, 1), a1 + hstepA, voffA);
            PG8_WAIT_V(8); PG8_WAIT_L(0); PG8_BAR; PG8_MMA(0, 0, At, B0); PG8_MMA(0, 1, At, B1); PG8_BAR; PG8_SCHED;
            PG8_LDA(At, 0, 1); PG8_STAGE(PG8_SB(0, 0), b2, voffB); PG8_STAGE(PG8_SB(0, 1), b2 + hstepB, voffB); PG8_STAGE(PG8_SA(0, 0), a2, voffA);
            PG8_WAIT_V(8); PG8_WAIT_L(0); PG8_BAR; PG8_MMA(1, 0, At, B0); PG8_MMA(1, 1, At, B1); PG8_BAR; PG8_SCHED;
            PG8_LDB(B0, 1, 0); PG8_LDB(B1, 1, 1); PG8_SCHED; PG8_LDA(At, 1, 0); PG8_STAGE(PG8_SA(0, 1), a2 + hstepA, voffA);
            PG8_WAIT_V(8); PG8_WAIT_L(0); PG8_BAR; PG8_MMA(0, 0, At, B0); PG8_MMA(0, 1, At, B1); PG8_BAR; PG8_SCHED;
            PG8_LDA(At, 1, 1); PG8_STAGE(PG8_SB(1, 0), b3, voffB); PG8_STAGE(PG8_SB(1, 1), b3 + hstepB, voffB); PG8_STAGE(PG8_SA(1, 0), a3, voffA);
            PG8_WAIT_V(8); PG8_WAIT_L(0); PG8_BAR; PG8_MMA(1, 0, At, B0); PG8_MMA(1, 1, At, B1); PG8_BAR; PG8_SCHED;
        }
        if (wr == 0) PG8_BAR;
        { const int l_e = fresh_lane();
          E(acc, cur, wr, wc, l_e & 15, l_e >> 4); }
        if (!has_next) break;
#pragma unroll
        for (int a = 0; a < 2; ++a)
#pragma unroll
            for (int b = 0; b < 2; ++b)
#pragma unroll
                for (int m = 0; m < 4; ++m)
#pragma unroll
                    for (int n = 0; n < 2; ++n) acc[a][b][m][n] = (f32x4){0.f, 0.f, 0.f, 0.f};
        cur = nxt; cA = nA; cB = nB; ++ui;
        if (wr == 1) PG8_BAR;
    }
    PG8_WAIT_V(0);
    PG8_BAR;
#undef PG8_SA
#undef PG8_SB
#undef PG8_STAGE
#undef PG8_LDA
#undef PG8_LDB
#undef PG8_MMA
#undef PG8_WAIT_V
#undef PG8_WAIT_L
#undef PG8_BAR
#undef PG8_SCHED
}
}

#define XB_TMO      128
#define XB_XCNT(j)  (256  + 64 * (j))
#define XB_XSUB(j)  (1280 + 64 * (j))
#define XB_XGEN(j)  (2304 + 64 * (j))
#define XB_TOP      3328
#define XB_TOPGEN   3392
#define XCD_BAR_WORDS 3456
#define XB_SPIN_CAP (1u << 22)
__device__ __forceinline__ unsigned xb_ld(unsigned* p)              { return __hip_atomic_load(p, __ATOMIC_RELAXED, __HIP_MEMORY_SCOPE_AGENT); }
__device__ __forceinline__ unsigned xb_add(unsigned* p, unsigned v) { return __hip_atomic_fetch_add(p, v, __ATOMIC_RELAXED, __HIP_MEMORY_SCOPE_AGENT); }
__device__ __forceinline__ unsigned xb_xcc_id() { return (unsigned)__builtin_amdgcn_s_getreg((3 << 11) | 20) & 0xFu; }
#define XB_SPIN(cond, bar) do { unsigned _sp = 0; while (cond) { __builtin_amdgcn_s_sleep(1); \
    if ((++_sp & 255u) == 0u) { if (xb_ld(&(bar)[XB_TMO])) break; if (_sp > XB_SPIN_CAP) { atomicAdd(&(bar)[XB_TMO], 1u); break; } } } } while (0)
struct XcdBarrier { unsigned* bar; unsigned x; volatile LAS unsigned* st; };
__device__ __forceinline__ XcdBarrier xcd_barrier_post(unsigned* bar, volatile LAS unsigned* st) {
    XcdBarrier b; b.bar = bar; b.x = xb_xcc_id(); b.st = st;
    if (threadIdx.x == 0) (void)xb_add(&bar[XB_XCNT(b.x)], 1u);
    return b;
}
__device__ __forceinline__ void xcd_barrier_complete(unsigned* bar, unsigned x, unsigned& nloc, unsigned& nx) {
    const unsigned G = gridDim.x * gridDim.y * gridDim.z;
    unsigned sum, cnt, mine, sp = 0u;
    for (;;) {
        sum = 0u; cnt = 0u; mine = 0u;
#pragma unroll
        for (unsigned j = 0; j < 16; ++j) { const unsigned c = xb_ld(&bar[XB_XCNT(j)]); sum += c; cnt += (c > 0u) ? 1u : 0u; }
        mine = xb_ld(&bar[XB_XCNT(x)]);
        if (sum == G) break;
        __builtin_amdgcn_s_sleep(1);
        if ((++sp & 255u) == 0u) { if (xb_ld(&bar[XB_TMO])) break; if (sp > XB_SPIN_CAP) { atomicAdd(&bar[XB_TMO], 1u); break; } }
    }
    nloc = mine > 0u ? mine : 1u; nx = cnt > 0u ? cnt : 1u;
}
__device__ __forceinline__ void xcd_barrier(const XcdBarrier& b, int wave) {
    asm volatile("s_waitcnt vmcnt(0)" ::: "memory");
    __syncthreads();
    if (wave == 0 && fresh_lane() == 0) {
        unsigned* bar = b.bar; asm volatile("" : "+s"(bar));
        __builtin_amdgcn_s_waitcnt(0);
        unsigned nloc = b.st[0], nx = b.st[1];
        if (nloc == 0u) { xcd_barrier_complete(bar, b.x, nloc, nx); b.st[0] = nloc; b.st[1] = nx; }
        const unsigned old = xb_add(&bar[XB_XSUB(b.x)], 1u);
        const unsigned gen = old / nloc;
        if (old + 1u == (gen + 1u) * nloc) {
            __builtin_amdgcn_fence(__ATOMIC_RELEASE, "agent");
            asm volatile("s_waitcnt vmcnt(0)" ::: "memory");
            const unsigned og = xb_add(&bar[XB_TOP], 1u);
            const unsigned tg = og / nx;
            if (og + 1u == (tg + 1u) * nx) xb_add(&bar[XB_TOPGEN], 1u);
            else XB_SPIN(xb_ld(&bar[XB_TOPGEN]) == tg, bar);
            __builtin_amdgcn_fence(__ATOMIC_ACQUIRE, "agent");
            xb_add(&bar[XB_XGEN(b.x)], 1u);
            asm volatile("s_waitcnt vmcnt(0)" ::: "memory");
        } else {
            XB_SPIN(xb_ld(&bar[XB_XGEN(b.x)]) == gen, bar);
            __builtin_amdgcn_fence(__ATOMIC_ACQUIRE, "agent");
            asm volatile("s_waitcnt vmcnt(0)" ::: "memory");
        }
    }
    __syncthreads();
}

struct Args {
    const float* x; const float* rel_bias; const float* mix_norm; const float* ffn_norm; const float* final_norm;
    const float* conv_w_in; const float* conv_kernel; const float* conv_w_out;
    const float* nsa_w_in; const float* cmp_pos_k; const float* cmp_pos_v; const float* cmp_w1_k; const float* cmp_w2_k; const float* cmp_w1_v; const float* cmp_w2_v; const float* nsa_w_out;
    const float* peer_w_q; const float* peer_sub_keys; const float* peer_u; const float* peer_v;
    float* out; unsigned char* ws; int ph_lo, ph_hi, li, pad;
};
struct Frame { LAS unsigned char* lds; int tid, lane, wave, vcu, G; };

struct TrItem { const float* W; const float* gain; bf16_t* WT; int K, Nsrc, k0, n0, sn0; };
__device__ __forceinline__ void tr_load(const TrItem& t, f32x4 (&tv)[8], int lane) {
#pragma unroll
    for (int i = 0; i < 8; ++i) { const int kk = 8 * i + (lane >> 3), col = 4 * (lane & 7); const float* p = t.W + (size_t)(t.k0 + kk) * t.Nsrc + t.sn0 + col;
        if (t.sn0 + col + 3 < t.Nsrc) tv[i] = *(const f32x4*)p;
        else { tv[i][0] = t.sn0 + col < t.Nsrc ? p[0] : 0.f; tv[i][1] = t.sn0 + col + 1 < t.Nsrc ? p[1] : 0.f; tv[i][2] = t.sn0 + col + 2 < t.Nsrc ? p[2] : 0.f; tv[i][3] = 0.f; } }
}
__device__ __forceinline__ void tr_finish(const TrItem& t, const f32x4 (&tv)[8], LAS float* scr, int lane) {
#pragma unroll
    for (int i = 0; i < 8; ++i) { const int kk = 8 * i + (lane >> 3), col = 4 * (lane & 7); const float gk = t.gain ? t.gain[t.k0 + kk] : 1.0f;
        scr[kk * 33 + col] = tv[i][0] * gk; scr[kk * 33 + col + 1] = tv[i][1] * gk; scr[kk * 33 + col + 2] = tv[i][2] * gk; scr[kk * 33 + col + 3] = tv[i][3] * gk; }
    LDS_WAIT(); asm volatile("" ::: "memory");
    const int c = lane & 7;
#pragma unroll
    for (int j = 0; j < 4; ++j) { const int n = (lane >> 3) + 8 * j; const LAS float* s = scr + (8 * c) * 33 + n;
        u32x4 o; o.x = cvtpk(s[0 * 33], s[1 * 33]); o.y = cvtpk(s[2 * 33], s[3 * 33]); o.z = cvtpk(s[4 * 33], s[5 * 33]); o.w = cvtpk(s[6 * 33], s[7 * 33]);
        *(u32x4*)(t.WT + (size_t)(t.n0 + n) * t.K + t.k0 + 8 * c) = o; }
    LDS_WAIT(); asm volatile("" ::: "memory");
}
__device__ __forceinline__ void tr_set(TrItem& t, const float* W, int K, int Nsrc, int Ndst, const float* gain, bf16_t* WT, int item, int mode) {
    const int nblk = Ndst / 32, kb = item / nblk, nb = item % nblk; t.W = W; t.gain = gain; t.WT = WT; t.K = K; t.Nsrc = Nsrc; t.k0 = 64 * kb; t.n0 = 32 * nb; t.sn0 = t.n0;
    if (mode == 1 && t.n0 >= 2048) { const int r = t.n0 - 2048, kk = r >> 8, xx = r & 255; t.sn0 = xx < 128 ? 2048 + 128 * kk + xx : 4096 + 128 * kk + (xx - 128); }
}

__device__ __forceinline__ void convert_expert_rows(const Args& a, unsigned char* ws, int lane, int row_lo, int row_hi, int rw, int nw, int reps) {
    for (int tb = 0; tb < 2 * reps; ++tb) {
        const float* src = (tb & 1) ? a.peer_v : a.peer_u; unsigned char* dst = ws + ((tb & 1) ? WS_VB : WS_UB); float* scl = (float*)(ws + ((tb & 1) ? WS_VSC : WS_USC));
#define EXP_LOAD(v_, row_) do { const float* sr = src + (size_t)(row_) * DM + 4 * lane; _Pragma("unroll") for (int j = 0; j < 2; ++j) _Pragma("unroll") for (int i = 0; i < 4; ++i) v_[j][i] = __builtin_nontemporal_load((const f32x4*)(sr + 256 * (i + 4 * j))); } while (0)
#define EXP_DONE(v_, row_) do { float ss = 0.f; \
            _Pragma("unroll") for (int j = 0; j < 2; ++j) _Pragma("unroll") for (int i = 0; i < 4; ++i) ss += (v_[j][i][0] * v_[j][i][0] + v_[j][i][1] * v_[j][i][1]) + (v_[j][i][2] * v_[j][i][2] + v_[j][i][3] * v_[j][i][3]); \
            ss = rows_total(row_sum16(ss)); \
            const float rms = __builtin_sqrtf(ss * (1.0f / DM)); u32x4 o; \
            if (tb & 1) { const float sc = rms > 0.f ? 2.0f / rms : 1.0f; \
                _Pragma("unroll") for (int i = 0; i < 4; ++i) { unsigned w_ = 0u; \
                    w_ = __builtin_amdgcn_cvt_scalef32_pk_fp4_f32(w_, v_[0][i][0] * sc, v_[1][i][0] * sc, 1.0f, 0); w_ = __builtin_amdgcn_cvt_scalef32_pk_fp4_f32(w_, v_[0][i][1] * sc, v_[1][i][1] * sc, 1.0f, 1); \
                    w_ = __builtin_amdgcn_cvt_scalef32_pk_fp4_f32(w_, v_[0][i][2] * sc, v_[1][i][2] * sc, 1.0f, 2); w_ = __builtin_amdgcn_cvt_scalef32_pk_fp4_f32(w_, v_[0][i][3] * sc, v_[1][i][3] * sc, 1.0f, 3); o[i] = w_; } \
                if (lane == 0) scl[row_] = rms > 0.f ? rms * 0.5f : 1.0f; \
            } else { const float step = 0.3352f * rms, sc = rms > 0.f ? 1.0f / step : 0.f; \
                _Pragma("unroll") for (int i = 0; i < 4; ++i) { unsigned w_ = 0u; \
                    _Pragma("unroll") for (int c = 0; c < 4; ++c) { const int q0 = (int)__builtin_fminf(__builtin_fmaxf(__builtin_floorf(v_[0][i][c] * sc), -8.0f), 7.0f), q1 = (int)__builtin_fminf(__builtin_fmaxf(__builtin_floorf(v_[1][i][c] * sc), -8.0f), 7.0f); \
                        w_ |= (((unsigned)q0 & 15u) | (((unsigned)q1 & 15u) << 4)) << (8 * c); } \
                    o[i] = w_; } \
                if (lane == 0) scl[row_] = step; } \
            *(u32x4*)(dst + (size_t)(row_) * EROW + 16 * lane) = o; } while (0)
        {
            f32x4 va[2][4], vb[2][4];
            int row = row_lo + rw;
            if (row < row_hi) EXP_LOAD(va, row);
            for (; row < row_hi; row += 2 * nw) {
                const int r1 = row + nw, r2 = row + 2 * nw;
                if (r1 < row_hi) EXP_LOAD(vb, r1);
                __builtin_amdgcn_sched_barrier(0);
                EXP_DONE(va, row);
                if (r2 < row_hi) EXP_LOAD(va, r2);
                __builtin_amdgcn_sched_barrier(0);
                if (r1 < row_hi) EXP_DONE(vb, r1);
            }
        }
#undef EXP_LOAD
#undef EXP_DONE
    }
}

__device__ __forceinline__ void p0_prologue(const Frame& F, const Args& a) {
    unsigned char* ws = a.ws;
    LAS float* scr = (LAS float*)(F.lds + F.wave * 16384);
    const int gw = F.vcu * 8 + F.wave, NGW = F.G * 8;
    for (int it = gw; it < 256; it += NGW) {
        const int chunk = it & 63, kv = (it >> 6) & 1, j = it >> 7;
        const float* pos = (kv ? a.cmp_pos_v : a.cmp_pos_k) + (size_t)j * 4096; const float* w1 = (kv ? a.cmp_w1_v : a.cmp_w1_k) + (size_t)j * 4096 * 256;
        f32x4 acc[8];
#pragma unroll
        for (int u = 0; u < 8; ++u) acc[u] = (f32x4){0.f, 0.f, 0.f, 0.f};
        for (int k = chunk * 64; k < chunk * 64 + 64; k += 8) {
#pragma unroll
            for (int u = 0; u < 8; ++u) acc[u] += *(const f32x4*)(w1 + (size_t)(k + u) * 256 + 4 * F.lane) * pos[k + u]; }
        *(f32x4*)((float*)(ws + WS_BIAS1P) + (size_t)it * 256 + 4 * F.lane) = ((acc[0] + acc[1]) + (acc[2] + acc[3])) + ((acc[4] + acc[5]) + (acc[6] + acc[7]));
    }
    constexpr int I_CIN = 32 * (NCIN / 32), I_SQ = 32 * (DM / 32), I_NIN = 32 * (NNPAD / 32), I_C1 = 64 * (256 / 32);
    constexpr int NIT = 2 * I_CIN + 2 * I_SQ + 2 * I_NIN + 2 * I_SQ + 4 * I_C1;
#define TR_DECODE(t_, it_) do { int r = (it_); \
        if (r < 2 * I_CIN) { const int j = r / I_CIN; r -= j * I_CIN; tr_set(t_, a.conv_w_in + (size_t)j * DM * NCIN, DM, NCIN, NCIN, a.mix_norm + (size_t)(2 * j) * DM, (bf16_t*)(ws + WS_WCIN) + (size_t)j * NCIN * DM, r, 1); break; } r -= 2 * I_CIN; \
        if (r < 2 * I_SQ) { const int j = r / I_SQ; r -= j * I_SQ; tr_set(t_, a.conv_w_out + (size_t)j * DM * DM, DM, DM, DM, nullptr, (bf16_t*)(ws + WS_WCOUT) + (size_t)j * DM * DM, r, 0); break; } r -= 2 * I_SQ; \
        if (r < 2 * I_NIN) { const int j = r / I_NIN; r -= j * I_NIN; tr_set(t_, a.nsa_w_in + (size_t)j * DM * NNIN, DM, NNIN, NNPAD, a.mix_norm + (size_t)(2 * j + 1) * DM, (bf16_t*)(ws + WS_WNIN) + (size_t)j * NNPAD * DM, r, 2); break; } r -= 2 * I_NIN; \
        if (r < 2 * I_SQ) { const int j = r / I_SQ; r -= j * I_SQ; tr_set(t_, a.nsa_w_out + (size_t)j * DM * DM, DM, DM, DM, nullptr, (bf16_t*)(ws + WS_WNOUT) + (size_t)j * DM * DM, r, 0); break; } r -= 2 * I_SQ; \
        { const int q = r / I_C1; r -= q * I_C1; const int j = q >> 1, kv = q & 1; tr_set(t_, (kv ? a.cmp_w1_v : a.cmp_w1_k) + (size_t)j * 4096 * 256, 4096, 256, 256, nullptr, (bf16_t*)(ws + WS_WC1) + (size_t)q * 256 * 4096, r, 0); } } while (0)
    for (int rep = 0; rep < (((PROBE_MASK >> 13) & 1) ? 2 : 1); ++rep) {
        TrItem ta, tb; f32x4 va[8], vb[8];
        int it = gw;
        if (it < NIT) { TR_DECODE(ta, it); tr_load(ta, va, F.lane); }
        for (; it < NIT; it += 2 * NGW) {
            const int i1 = it + NGW, i2 = it + 2 * NGW;
            if (i1 < NIT) { TR_DECODE(tb, i1); tr_load(tb, vb, F.lane); }
            __builtin_amdgcn_sched_barrier(0);
            tr_finish(ta, va, scr, F.lane);
            if (i2 < NIT) { TR_DECODE(ta, i2); tr_load(ta, va, F.lane); }
            __builtin_amdgcn_sched_barrier(0);
            if (i1 < NIT) tr_finish(tb, vb, scr, F.lane);
        }
    }
#undef TR_DECODE
    const size_t gt = (size_t)F.vcu * 512 + F.tid, NGT = (size_t)F.G * 512;
    for (size_t ch = gt; ch < (size_t)DEPTH * DM * DM / 8; ch += 2 * NGT) {
        f32x4 v[2][2]; float gk[2];
#pragma unroll
        for (int q = 0; q < 2; ++q) { const size_t e = (ch + q * NGT) * 8; const int i = (int)(e / ((size_t)DM * DM)), k = (int)((e / DM) % DM); gk[q] = a.ffn_norm[i * DM + k];
            v[q][0] = *(const f32x4*)(a.peer_w_q + e); v[q][1] = *(const f32x4*)(a.peer_w_q + e + 4); }
#pragma unroll
        for (int q = 0; q < 2; ++q) { const size_t e = (ch + q * NGT) * 8; const f32x4 v0 = v[q][0] * gk[q], v1 = v[q][1] * gk[q];
            u32x4 o; o.x = cvtpk(v0[0], v0[1]); o.y = cvtpk(v0[2], v0[3]); o.z = cvtpk(v1[0], v1[1]); o.w = cvtpk(v1[2], v1[3]);
            *(u32x4*)((bf16_t*)(ws + WS_WQN) + e) = o; }
    }
    for (size_t ch = gt; ch < (size_t)DEPTH * 2048 * 256 / 8; ch += NGT) {
        const size_t e = ch * 8; const int col = (int)(e & 255), row = (int)((e >> 8) & 2047), i = (int)(e >> 19);
        const int p = (row >> 7) & 1; u32x4 o = (u32x4){0u, 0u, 0u, 0u};
        if ((col >> 7) == p) { const float* src = a.peer_sub_keys + ((size_t)i * 2048 + row) * 128 + (col & 127);
            const f32x4 v0 = *(const f32x4*)src, v1 = *(const f32x4*)(src + 4);
            o.x = cvtpk(v0[0], v0[1]); o.y = cvtpk(v0[2], v0[3]); o.z = cvtpk(v1[0], v1[1]); o.w = cvtpk(v1[2], v1[3]); }
        *(u32x4*)((bf16_t*)(ws + WS_KEYSPAD) + e) = o;
    }
    convert_expert_rows(a, ws, F.lane, 0, 2 * NEXP, gw, NGW, ((PROBE_MASK >> 12) & 1) ? 2 : 1);
    for (int m = gw; m < T; m += NGW) {
        const float* xr = a.x + (size_t)m * DM; bf16_t* hb = (bf16_t*)(ws + WS_HB) + (size_t)m * DM; float s = 0.f;
#pragma unroll
        for (int j = 0; j < 4; ++j) { const int e0 = 512 * j + 8 * F.lane; const f32x4 v0 = *(const f32x4*)(xr + e0), v1 = *(const f32x4*)(xr + e0 + 4);
            s += (v0[0] * v0[0] + v0[1] * v0[1]) + (v0[2] * v0[2] + v0[3] * v0[3]) + (v1[0] * v1[0] + v1[1] * v1[1]) + (v1[2] * v1[2] + v1[3] * v1[3]);
            u32x4 o; o.x = cvtpk(v0[0], v0[1]); o.y = cvtpk(v0[2], v0[3]); o.z = cvtpk(v1[0], v1[1]); o.w = cvtpk(v1[2], v1[3]); *(u32x4*)(hb + e0) = o; }
        s = wave_sum(s);
        if (F.lane < 32) ((float*)(ws + WS_SSQ))[(size_t)m * 32 + F.lane] = F.lane == 0 ? s : 0.f;
    }
}

template <class Sched>
__device__ __forceinline__ void fill_rstd(const Frame& F, const Sched& S, const float* ssq) {
    LAS float* rs = (LAS float*)(F.lds + RS_OFF);
    pg8::Unit u;
    for (int i = 0; S.next(i, u); ++i) {
        if (F.tid < 256) { const f32x4* p = (const f32x4*)(ssq + ((size_t)u.pm * 256 + F.tid) * 32); float s = 0.f;
#pragma unroll
            for (int k = 0; k < 8; ++k) { const f32x4 v = p[k]; s += (v[0] + v[1]) + (v[2] + v[3]); }
            rs[i * 256 + F.tid] = rsqrtf(s * (1.0f / DM) + EPS); }
    }
    __syncthreads();
}

__device__ __forceinline__ void conv_gate_phase(const Frame& F, const bf16_t* Bg, const bf16_t* Z, const float* ck, bf16_t* Y) {
    const int gt = F.vcu * 512 + F.tid, NGT = F.G * 512;
    for (int it = gt; it < (T / 16) * 256; it += NGT) {
        const int c8 = (it & 255) * 8, r0 = (it >> 8) * 16, s0 = r0 & (SEQ - 1);
        float k0[8], k1[8], k2[8];
        *(f32x4*)k0 = *(const f32x4*)(ck + c8); *(f32x4*)(k0 + 4) = *(const f32x4*)(ck + c8 + 4);
        *(f32x4*)k1 = *(const f32x4*)(ck + DM + c8); *(f32x4*)(k1 + 4) = *(const f32x4*)(ck + DM + c8 + 4);
        *(f32x4*)k2 = *(const f32x4*)(ck + 2 * DM + c8); *(f32x4*)(k2 + 4) = *(const f32x4*)(ck + 2 * DM + c8 + 4);
        u32x4 z1 = (u32x4){0u, 0u, 0u, 0u}, z2 = z1;
        if (s0 >= 1) z1 = *(const u32x4*)(Z + (size_t)(r0 - 1) * DM + c8);
        if (s0 >= 2) z2 = *(const u32x4*)(Z + (size_t)(r0 - 2) * DM + c8);
#pragma unroll
        for (int h = 0; h < 2; ++h) {
            u32x4 zz[8], bb[8];
#pragma unroll
            for (int i = 0; i < 8; ++i) { zz[i] = *(const u32x4*)(Z + (size_t)(r0 + 8 * h + i) * DM + c8); bb[i] = *(const u32x4*)(Bg + (size_t)(r0 + 8 * h + i) * DM + c8); }
#pragma unroll
            for (int i = 0; i < 8; ++i) {
                const u32x4 z0 = zz[i], bg = bb[i]; u32x4 o;
#pragma unroll
                for (int j = 0; j < 4; ++j) {
                    const float lo = bf_lo(bg[j]) * (k0[2 * j] * bf_lo(z2[j]) + k1[2 * j] * bf_lo(z1[j]) + k2[2 * j] * bf_lo(z0[j]));
                    const float hi = bf_hi(bg[j]) * (k0[2 * j + 1] * bf_hi(z2[j]) + k1[2 * j + 1] * bf_hi(z1[j]) + k2[2 * j + 1] * bf_hi(z0[j]));
                    o[j] = cvtpk(lo, hi);
                }
                *(u32x4*)(Y + (size_t)(r0 + 8 * h + i) * DM + c8) = o;
                z2 = z1; z1 = z0;
            }
        }
    }
}

__device__ __forceinline__ void cmp_finalize_phase(const Frame& F, const bf16_t* slab, const float* bias1p  , const float* w2k, const float* w2v, bf16_t* KC, bf16_t* VC) {
    LAS float* bpart = (LAS float*)(F.lds);
    LAS unsigned char* hid = F.lds + 8192;
    const int w = F.wave;
    for (int it = F.vcu; it < 256; it += F.G) {
        int ln = F.lane; asm volatile("" : "+v"(ln));
        const int kv = it >> 7, row0 = (it & 127) * 16;
        __syncthreads();
        u32x2 hv[2][8];
#pragma unroll
        for (int rr = 0; rr < 2; ++rr)
#pragma unroll
            for (int ks = 0; ks < 8; ++ks) hv[rr][ks] = *(const u32x2*)(slab + ((size_t)(ks * 2 + kv) * 2048 + row0 + 2 * w + rr) * 256 + 4 * ln);
        { f32x4 bs = (f32x4){0.f, 0.f, 0.f, 0.f};
#pragma unroll
          for (int c = 0; c < 8; ++c) bs += *(const f32x4*)(bias1p + ((size_t)kv * 64 + 8 * w + c) * 256 + 4 * ln);
          *(LAS f32x4*)(bpart + w * 256 + 4 * ln) = bs; }
        const float* w2 = (kv ? w2v : w2k) + 16 * w + (ln & 15) + (size_t)(8 * (ln >> 4)) * 128;
        float wf[8][8];
#pragma unroll
        for (int s_ = 0; s_ < 8; ++s_)
#pragma unroll
            for (int j = 0; j < 8; ++j) wf[s_][j] = w2[(size_t)(32 * s_ + j) * 128];
        __syncthreads();
        f32x4 bias = (f32x4){0.f, 0.f, 0.f, 0.f};
#pragma unroll
        for (int c = 0; c < 8; ++c) bias += *(const LAS f32x4*)(bpart + c * 256 + 4 * ln);
#pragma unroll
        for (int rr = 0; rr < 2; ++rr) {
            f32x4 h = bias;
#pragma unroll
            for (int ks = 0; ks < 8; ++ks) { h[0] += bf_lo(hv[rr][ks].x); h[1] += bf_hi(hv[rr][ks].x); h[2] += bf_lo(hv[rr][ks].y); h[3] += bf_hi(hv[rr][ks].y); }
            u32x2 o; o.x = cvtpk(gelu_tanh(h[0]), gelu_tanh(h[1])); o.y = cvtpk(gelu_tanh(h[2]), gelu_tanh(h[3]));
            *(LAS u32x2*)(hid + (2 * w + rr) * 528 + 8 * ln) = o;
        }
        __syncthreads();
        f32x4 acc = (f32x4){0.f, 0.f, 0.f, 0.f};
        const int fr = ln & 15, fq = ln >> 4;
#pragma unroll
        for (int s_ = 0; s_ < 8; ++s_) {
            const bf16x8 hf = *(const LAS bf16x8*)(hid + fr * 528 + 64 * s_ + 16 * fq);
            u32x4 wp; wp.x = cvtpk(wf[s_][0], wf[s_][1]); wp.y = cvtpk(wf[s_][2], wf[s_][3]); wp.z = cvtpk(wf[s_][4], wf[s_][5]); wp.w = cvtpk(wf[s_][6], wf[s_][7]);
            acc = __builtin_amdgcn_mfma_f32_16x16x32_bf16(__builtin_bit_cast(bf16x8, wp), hf, acc, 0, 0, 0);
        }
        const int row = row0 + fr;
        u32x2 o; o.x = cvtpk(acc[0], acc[1]); o.y = cvtpk(acc[2], acc[3]);
        if ((row & 255) == 255) o = (u32x2){0u, 0u};
        *(u32x2*)((kv ? VC : KC) + (size_t)row * 128 + 16 * w + 4 * fq) = o;
    }
}

namespace att {
constexpr int KS0 = 0  , VS0 = 32768  , STG = 81920, STGW = 32 * 272, IMPA = STG, IMPC = STG + 16384  , MASK = STG + 8 * STGW, LUT = MASK + 512;
static_assert(LUT + 2048 <= RING_BYTES && IMPC + 16384 <= MASK, "attention LDS");
constexpr float NEG = -1e30f, DEFER_THR = 8.0f;
__device__ __forceinline__ unsigned off_a(unsigned row, unsigned ch) { return 2048u * (row >> 3) + 512u * (ch >> 2) + 64u * (row & 7u) + 16u * ((ch & 3u) ^ ((row >> 2) & 3u)); }
__device__ __forceinline__ s16x4 vtr(const LAS unsigned char* p) { return __builtin_bit_cast(s16x4, __builtin_amdgcn_ds_read_tr16_b64_v4i16((LAS v4i16_t*)p)); }
__device__ __forceinline__ int t5_bucket(int d) {
    if (d < 16) return d;
    int b = 16;
    b += d >= 19; b += d >= 21; b += d >= 24; b += d >= 27; b += d >= 31; b += d >= 35; b += d >= 40; b += d >= 46; b += d >= 52; b += d >= 59; b += d >= 67; b += d >= 77; b += d >= 87; b += d >= 99; b += d >= 113;
    return b;
}
__device__ __forceinline__ unsigned dma_src_off(unsigned s) {
    const unsigned rhi = s >> 7, chi = (s >> 5) & 3u, rlo = (s >> 2) & 7u, cx = s & 3u, row = (rhi << 3) | rlo, x = ((row >> 2) & 3u), ch = (chi << 2) | (cx ^ x);
    return row * 256u + ch * 16u;
}
template <bool WITHV> __device__ __forceinline__ void tile_dma(LAS unsigned char* lds, int ks, int vs, const bf16_t* kb, const bf16_t* vb, const unsigned (&goff)[2], int w) {
#pragma unroll
    for (int i = 0; i < 2; ++i) {
        __builtin_amdgcn_global_load_lds((const unsigned*)((const char*)kb + goff[i]), (LAS unsigned*)(lds + KS0 + ks * 16384 + (8 * i + w) * 1024), 16, 0, 0);
        if (WITHV) __builtin_amdgcn_global_load_lds((const unsigned*)((const char*)vb + goff[i]), (LAS unsigned*)(lds + VS0 + vs * 16384 + (8 * i + w) * 1024), 16, 0, 0);
    }
}
#define ATT_WAITBAR() asm volatile("s_waitcnt vmcnt(0) lgkmcnt(0)\n\ts_barrier" ::: "memory")
__device__ __forceinline__ void qk_tiles(f32x16& s0, f32x16& s1, const LAS unsigned char* lds, const bf16x8 (&qf)[8], int lane, float init = 0.f) {
    const unsigned r32 = lane & 31, hh = lane >> 5;
    const unsigned b0 = 2048u * (r32 >> 3) + 64u * (r32 & 7u) + 16u * ((0u + hh) ^ ((r32 >> 2) & 3u)), b1 = 2048u * (r32 >> 3) + 64u * (r32 & 7u) + 16u * ((2u + hh) ^ ((r32 >> 2) & 3u));
    bf16x8 k0[8], k1[8];
#pragma unroll
    for (int ks = 0; ks < 8; ++ks) k0[ks] = *(const LAS bf16x8*)(lds + ((ks & 1) ? b1 : b0) + 512u * (ks >> 1));
#pragma unroll
    for (int ks = 0; ks < 4; ++ks) k1[ks] = *(const LAS bf16x8*)(lds + ((ks & 1) ? b1 : b0) + 8192u + 512u * (ks >> 1));
    __builtin_amdgcn_sched_barrier(0);
#pragma unroll
    for (int i = 0; i < 16; ++i) { s0[i] = init; s1[i] = init; }
#pragma unroll
    for (int ks = 0; ks < 8; ++ks) s0 = __builtin_amdgcn_mfma_f32_32x32x16_bf16(k0[ks], qf[ks], s0, 0, 0, 0);
    __builtin_amdgcn_sched_barrier(0);
#pragma unroll
    for (int ks = 4; ks < 8; ++ks) k1[ks] = *(const LAS bf16x8*)(lds + ((ks & 1) ? b1 : b0) + 8192u + 512u * (ks >> 1));
#pragma unroll
    for (int ks = 0; ks < 8; ++ks) s1 = __builtin_amdgcn_mfma_f32_32x32x16_bf16(k1[ks], qf[ks], s1, 0, 0, 0);
    __builtin_amdgcn_sched_barrier(0);
}
__device__ __forceinline__ bf16x8 pack8(const f32x16& p, int s) {
    u32x4 w; w.x = cvtpk(p[8 * s + 0], p[8 * s + 1]); w.y = cvtpk(p[8 * s + 2], p[8 * s + 3]); w.z = cvtpk(p[8 * s + 4], p[8 * s + 5]); w.w = cvtpk(p[8 * s + 6], p[8 * s + 7]);
    return __builtin_bit_cast(bf16x8, w);
}
__device__ __forceinline__ void pack_p(bf16x8 (&pf)[4], const f32x16& p0, const f32x16& p1) {
#pragma unroll
    for (int c = 0; c < 4; ++c) pf[c] = pack8((c >> 1) ? p1 : p0, c & 1);
}
__device__ __forceinline__ void pv_mma(f32x16 (&O)[4], const LAS unsigned char* vt, const bf16x8 (&pf)[4], int lane) {
    const unsigned hh = lane >> 5, blk = (lane >> 4) & 1, q = (lane & 15) >> 2, p = lane & 3;
    const unsigned bv0 = 64u * (4u * hh + q) + 16u * ((2u * blk + (p >> 1)) ^ ((0u + hh) & 3u)) + 8u * (p & 1u);
    const unsigned bv1 = 64u * (4u * hh + q) + 16u * ((2u * blk + (p >> 1)) ^ ((2u + hh) & 3u)) + 8u * (p & 1u);
#pragma unroll
    for (int h2 = 0; h2 < 2; ++h2) {
        bf16x8 va[2][4];
#pragma unroll
        for (int c = 0; c < 2; ++c)
#pragma unroll
            for (int dt = 0; dt < 4; ++dt) { const s16x4 lo = vtr(vt + bv0 + 2048u * (2 * (c + 2 * h2)) + 512u * dt), hi = vtr(vt + bv1 + 2048u * (2 * (c + 2 * h2) + 1) + 512u * dt); va[c][dt] = __builtin_shufflevector(lo, hi, 0, 1, 2, 3, 4, 5, 6, 7); }
        __builtin_amdgcn_sched_barrier(0);
#pragma unroll
        for (int c = 0; c < 2; ++c)
#pragma unroll
            for (int dt = 0; dt < 4; ++dt) O[dt] = __builtin_amdgcn_mfma_f32_32x32x16_bf16(va[c][dt], pf[c + 2 * h2], O[dt], 0, 0, 0);
        __builtin_amdgcn_sched_barrier(0);
    }
}
__device__ __forceinline__ float xmax32(float v) { auto rr = __builtin_amdgcn_permlane32_swap(__float_as_uint(v), __float_as_uint(v), false, false); return __builtin_fmaxf(__uint_as_float(rr[0]), __uint_as_float(rr[1])); }
__device__ __forceinline__ float xsum32(float v) { auto rr = __builtin_amdgcn_permlane32_swap(__float_as_uint(v), __float_as_uint(v), false, false); return __uint_as_float(rr[0]) + __uint_as_float(rr[1]); }
__device__ __forceinline__ int crow(int reg, int hh) { return (reg & 3) + 8 * (reg >> 2) + 4 * hh; }

template <int BR> __device__ __forceinline__ void tile_fix(f32x16& s, int pos0, int tq, int hh, bool near, bool masked, bool lanesel, const LAS float* lut) {
    if (near || masked) {
        constexpr int STEP = BR == 0 ? 16 : 1;
        int d0 = tq - (BR == 0 ? 16 * pos0 + 31 : pos0) - STEP * 4 * hh;
        asm volatile("" : "+v"(d0));
#pragma unroll
        for (int i = 0; i < 16; ++i) {
            const int dist = d0 - STEP * ((i & 3) + 8 * (i >> 2));
            bool ok = dist >= 0; if (BR == 2) ok = ok && dist < 512; if (BR == 1) ok = ok && lanesel;
            float v = s[i];
            if (near) { const int dc = dist < 0 ? 0 : (dist > 127 ? 127 : dist); v += lut[dc]; }
            s[i] = ok ? v : NEG;
        }
    }
}

template <int BR> __device__ __forceinline__ void online_front(f32x16 (&O)[4], float& m, float& l, bf16x8 (&pf)[4], const LAS unsigned char* kt, const bf16x8 (&qf)[8], int lane, int pos0, int tq, bool near, bool masked, bool lanesel, const LAS float* lut) {
    const int hh = lane >> 5;
    const bool fresh = m <= -1e20f;
    const float ref = lanesel ? (fresh ? 0.f : m) : 1e30f;
    f32x16 s0, s1; qk_tiles(s0, s1, kt, qf, lane, -ref);
    tile_fix<BR>(s0, pos0, tq, hh, near, masked, true, lut); tile_fix<BR>(s1, pos0 + 32, tq, hh, near, masked, true, lut);
    float mx = NEG;
#pragma unroll
    for (int i = 0; i < 16; ++i) { mx = __builtin_fmaxf(mx, s0[i]); mx = __builtin_fmaxf(mx, s1[i]); }
    mx = lanesel ? mx : NEG;
    mx = xmax32(mx);
    const bool grow = fresh ? (mx > -1e20f) : (mx > DEFER_THR);
    if (__any(grow)) {
        const float shift = grow ? mx : 0.f, alpha = fresh ? 1.0f : __builtin_amdgcn_exp2f(-shift);
        m = grow ? ref + mx : m; l *= alpha;
#pragma unroll
        for (int dt = 0; dt < 4; ++dt)
#pragma unroll
            for (int i = 0; i < 16; ++i) O[dt][i] *= alpha;
#pragma unroll
        for (int i = 0; i < 16; ++i) { s0[i] -= shift; s1[i] -= shift; }
    }
    float ps = 0.f;
#pragma unroll
    for (int i = 0; i < 16; ++i) { s0[i] = __builtin_amdgcn_exp2f(s0[i]); s1[i] = __builtin_amdgcn_exp2f(s1[i]); ps += s0[i] + s1[i]; }
    l += ps;
    pack_p(pf, s0, s1);
}

__device__ __forceinline__ unsigned stg_off(int row, int dt, int rg, int hh) { return (unsigned)row * 272u + (unsigned)((4 * dt + rg) * 16) + 8u * hh; }
template <bool ACCUM> __device__ __forceinline__ void stage_out(LAS unsigned char* stg, const f32x16 (&O)[4], float scale, int lane) {
    const int row = lane & 31, hh = lane >> 5;
#pragma unroll
    for (int dt = 0; dt < 4; ++dt)
#pragma unroll
        for (int rg = 0; rg < 4; ++rg) {
            LAS u32x2* p = (LAS u32x2*)(stg + stg_off(row, dt, rg, hh));
            float a0 = O[dt][4 * rg] * scale, a1 = O[dt][4 * rg + 1] * scale, a2 = O[dt][4 * rg + 2] * scale, a3 = O[dt][4 * rg + 3] * scale;
            if (ACCUM) { const u32x2 old = *p; a0 += bf_lo(old.x); a1 += bf_hi(old.x); a2 += bf_lo(old.y); a3 += bf_hi(old.y); }
            u32x2 w; w.x = cvtpk(a0, a1); w.y = cvtpk(a2, a3); *p = w;
        }
}

template <int SKIP> __device__ __forceinline__ void attn_phase(const Frame& F, const bf16_t* Q, const bf16_t* KV, const bf16_t* KC, const bf16_t* VC, const float* gates, const float* rel_bias, bf16_t* Oout) {
    LAS unsigned char* lds = F.lds;
    const int tid = F.tid, lane = F.lane, w = F.wave, hh = lane >> 5, qrow = lane & 31, ql = qrow >> 2, r = qrow & 3;
    LAS float* impA = (LAS float*)(lds + IMPA); LAS float* impC = (LAS float*)(lds + IMPC);
    LAS unsigned char* maskb = lds + MASK; LAS float* lutall = (LAS float*)(lds + LUT);
    LAS unsigned char* stg = lds + STG + w * STGW;
#define SEC_BEGIN ln = lane; asm volatile("" : "+v"(ln)); td = w * 64 + ln
    const int nun = F.G == 256 ? 2 : (512 - (int)blockIdx.x + F.G - 1) / F.G;
    for (int ui = 0; ui < nun; ++ui) {
        const int unit = F.G == 256 ? ((int)(blockIdx.x & 7) * 64 + (ui == 0 ? 63 - (int)(blockIdx.x >> 3) : (int)(blockIdx.x >> 3))) : (int)blockIdx.x + ui * F.G;
        int ln, td;
        const int bg = unit >> 6, qi = unit & 63, b = bg >> 2, g = bg & 3, t0 = qi * 64;
        const int tq = t0 + 8 * w + ql; const size_t trow = (size_t)b * SEQ + tq; const int head = g * 4 + r;
        const bf16_t* kcb = KC + (size_t)bg * 256 * 128; const bf16_t* vcb = VC + (size_t)bg * 256 * 128;
        const bf16_t* ksb = KV + (size_t)((2 * 2 + b) * 4 + g) * 4096 * 128; const bf16_t* vsb = KV + (size_t)((3 * 2 + b) * 4 + g) * 4096 * 128;
        const bf16_t* kwb = KV + (size_t)((4 * 2 + b) * 4 + g) * 4096 * 128; const bf16_t* vwb = KV + (size_t)((5 * 2 + b) * 4 + g) * 4096 * 128;
        __syncthreads();
        SEC_BEGIN;
        unsigned goff[2];
#pragma unroll
        for (int i = 0; i < 2; ++i) goff[i] = dma_src_off((unsigned)((8 * i + w) * 64 + ln));
        int st = 0;
        tile_dma<false>(lds, st, st, kcb, nullptr, goff, w);
        { const int rr = td >> 7, d = td & 127; const int hd = g * 4 + rr; lutall[td] = (rel_bias[t5_bucket(d) * 16 + hd] - rel_bias[31 * 16 + hd]) * LOG2E; }
        for (int i = td; i < 8192; i += 512) ((LAS float*)(lds + IMPA))[i] = 0.f;
        const LAS float* lut = lutall + r * 128;
        bf16x8 qf[8];
#pragma unroll
        for (int ks = 0; ks < 8; ++ks) qf[ks] = *(const bf16x8*)(Q + trow * DM + head * 128 + 16 * ks + 8 * hh);
        const float g0 = gates[trow * 48 + head], g1 = gates[trow * 48 + 16 + head], g2 = gates[trow * 48 + 32 + head];
        const int tq_lo = t0 + 8 * w, tq_hi = tq_lo + 7;
        const int nbc = (4 * qi + 2) / 64 + 1;
        float m = NEG, l = 0.f;
        for (int jb = 0; jb < nbc; ++jb) {
            ATT_WAITBAR();
            if (jb + 1 < nbc) tile_dma<false>(lds, st ^ 1, st ^ 1, kcb + (size_t)(jb + 1) * 64 * 128, nullptr, goff, w);
            else tile_dma<true>(lds, st ^ 1, st ^ 1, kcb, vcb, goff, w);
            const LAS unsigned char* sl = lds + KS0 + st * 16384; const LAS unsigned char* vl = lds + VS0 + st * 16384; (void)vl; st ^= 1;
            const int c0 = 64 * jb;
            if (!(SKIP & 4) && 16 * c0 + 31 <= tq_hi) {
                f32x16 s0, s1; qk_tiles(s0, s1, sl, qf, ln);
                const bool near0 = tq_lo - (16 * (c0 + 31) + 31) < 113, near1 = tq_lo - (16 * (c0 + 63) + 31) < 113;
                const bool mk0 = 16 * (c0 + 31) + 31 > tq_lo, mk1 = 16 * (c0 + 63) + 31 > tq_lo;
                tile_fix<0>(s0, c0, tq, hh, near0, mk0, true, lut); tile_fix<0>(s1, c0 + 32, tq, hh, near1, mk1, true, lut);
                float mx = NEG;
#pragma unroll
                for (int i = 0; i < 16; ++i) { mx = __builtin_fmaxf(mx, s0[i]); mx = __builtin_fmaxf(mx, s1[i]); }
                mx = xmax32(mx);
                const float mn = __builtin_fmaxf(m, mx), alpha = __builtin_amdgcn_exp2f(m - mn); m = mn;
                const float mu = __builtin_fmaxf(mn, -1e20f);
                float ps = 0.f;
#pragma unroll
                for (int i = 0; i < 16; ++i) { ps += __builtin_amdgcn_exp2f(s0[i] - mu); ps += __builtin_amdgcn_exp2f(s1[i] - mu); }
                l = l * alpha + ps;
            }
        }
        l = xsum32(l);
        const float invl = l > 0.f ? 1.0f / l : 0.f;
        f32x16 O[4];
#pragma unroll
        for (int dt = 0; dt < 4; ++dt)
#pragma unroll
            for (int i = 0; i < 16; ++i) O[dt][i] = 0.f;
        SEC_BEGIN;
        for (int jb = 0; jb < nbc; ++jb) {
            ATT_WAITBAR();
            if (jb + 1 < nbc) tile_dma<true>(lds, st ^ 1, st ^ 1, kcb + (size_t)(jb + 1) * 64 * 128, vcb + (size_t)(jb + 1) * 64 * 128, goff, w);
            else tile_dma<true>(lds, st ^ 1, st ^ 1, ksb, vsb, goff, w);
            const LAS unsigned char* sl = lds + KS0 + st * 16384; const LAS unsigned char* vl = lds + VS0 + st * 16384; st ^= 1;
            const int c0 = 64 * jb;
            if (!(SKIP & 4) && 16 * c0 + 31 <= tq_hi) {
                f32x16 s0, s1; qk_tiles(s0, s1, sl, qf, ln);
                const bool near0 = tq_lo - (16 * (c0 + 31) + 31) < 113, near1 = tq_lo - (16 * (c0 + 63) + 31) < 113;
                const bool mk0 = 16 * (c0 + 31) + 31 > tq_lo, mk1 = 16 * (c0 + 63) + 31 > tq_lo;
                tile_fix<0>(s0, c0, tq, hh, near0, mk0, true, lut); tile_fix<0>(s1, c0 + 32, tq, hh, near1, mk1, true, lut);
                const float mu = __builtin_fmaxf(m, -1e20f);
#pragma unroll
                for (int i = 0; i < 16; ++i) { s0[i] = __builtin_amdgcn_exp2f(s0[i] - mu) * invl; s1[i] = __builtin_amdgcn_exp2f(s1[i] - mu) * invl; }
#pragma unroll
                for (int kt = 0; kt < 2; ++kt)
#pragma unroll
                    for (int rg = 0; rg < 4; ++rg) {
                        const f32x16& p = kt ? s1 : s0;
                        float gs = (p[4 * rg] + p[4 * rg + 1]) + (p[4 * rg + 2] + p[4 * rg + 3]); float cy = p[4 * rg + 3];
                        gs += __shfl_xor(gs, 1); gs += __shfl_xor(gs, 2); cy += __shfl_xor(cy, 1); cy += __shfl_xor(cy, 2);
                        const int j = 16 * jb + 8 * kt + 2 * rg + hh;
                        if (r == 0) { impA[(8 * w + ql) * 64 + j] = gs; if (j + 1 < 64) impC[(8 * w + ql) * 64 + j + 1] = cy; }
                    }
                { bf16x8 pfc[4]; pack_p(pfc, s0, s1); pv_mma(O, vl, pfc, ln); }
            }
        }
        __syncthreads();
        SEC_BEGIN;
        {
            for (int i = td; i < 4096; i += 512) { const int j = i & 63;
                const bool forced = (j == 0) || (j == qi) || (j == qi - 1); const float imp = impA[i] + impC[i];
                impA[i] = forced ? 1e4f : (j <= qi ? imp : -1.0f); }
            __syncthreads();
            const int q = td >> 3, part = td & 7; unsigned bits = 0u;
            f32x4 rowv[16];
#pragma unroll
            for (int c = 0; c < 16; ++c) rowv[c] = *(const LAS f32x4*)(impA + q * 64 + 4 * c);
#pragma unroll
            for (int jj = 0; jj < 8; ++jj) { const int j = part * 8 + jj; const float sj = impA[q * 64 + j]; int gt = 0, eq = 0;
#pragma unroll
                for (int c = 0; c < 16; ++c)
#pragma unroll
                    for (int x = 0; x < 4; ++x) { const float s2 = rowv[c][x]; gt += s2 > sj ? 1 : 0; eq += s2 == sj ? 1 : 0; }
                bool sel = gt + eq <= 16;
                if (!sel && gt < 16 && j <= qi) {
                    int rank = gt;
#pragma nounroll
                    for (int j2 = 0; j2 < j; ++j2) rank += impA[q * 64 + j2] == sj ? 1 : 0;
                    sel = rank < 16; }
                bits |= ((sel && j <= qi) ? 1u : 0u) << jj; }
            maskb[q * 8 + part] = (unsigned char)bits;
            __syncthreads();
        }
        stage_out<false>(stg, O, g0, ln);
        const unsigned long long causal_mask = qi >= 63 ? ~0ull : ((2ull << qi) - 1ull);
        const unsigned long long mymask = *(const LAS unsigned long long*)(maskb + (8 * w + ql) * 8) & causal_mask;
        unsigned long long uni = *(const LAS unsigned long long*)(maskb + (ln & 63) * 8) & causal_mask;
#pragma unroll
        for (int o = 1; o < 64; o <<= 1) { const unsigned lo = __shfl_xor((unsigned)uni, o), hi = __shfl_xor((unsigned)(uni >> 32), o); uni |= ((unsigned long long)hi << 32) | lo; }
        unsigned long long wuni = mymask;
#pragma unroll
        for (int o = 4; o < 32; o <<= 1) { const unsigned lo = __shfl_xor((unsigned)wuni, o), hi = __shfl_xor((unsigned)(wuni >> 32), o); wuni |= ((unsigned long long)hi << 32) | lo; }
        uni = ((unsigned long long)__builtin_amdgcn_readfirstlane((unsigned)(uni >> 32)) << 32) | (unsigned)__builtin_amdgcn_readfirstlane((unsigned)uni);
        wuni = ((unsigned long long)__builtin_amdgcn_readfirstlane((unsigned)(wuni >> 32)) << 32) | (unsigned)__builtin_amdgcn_readfirstlane((unsigned)wuni);
        const int jlo = qi >= 8 ? qi - 8 : 0;
#define ATT_STEP(BR_, need_, pos0_, near_, masked_, lanesel_) do { \
            const LAS unsigned char* kt_ = lds + KS0 + kc * 16384; const LAS unsigned char* vt_ = lds + VS0 + vc * 16384; \
            int lq = ln; asm volatile("" : "+v"(lq));     \
            if (!late_c) { if (need_) { bf16x8 pf_[4]; online_front<BR_>(O, m, l, pf_, kt_, qf, lq, pos0_, tq, near_, masked_, lanesel_, lut); pv_mma(O, vt_, pf_, lq); } } \
            else { if (pend) pv_mma(O, lds + VS0 + vprev * 16384, pfl, lq); \
                   if (need_) online_front<BR_>(O, m, l, pfl, kt_, qf, lq, pos0_, tq, near_, masked_, lanesel_, lut); \
                   pend = (need_); vprev = vc; } \
            kc ^= 1; vc = vc == 2 ? 0 : vc + 1; } while (0)
#define ATT_FLUSH() do { if (late_c && pend) { int lq = ln; asm volatile("" : "+v"(lq)); pv_mma(O, lds + VS0 + vprev * 16384, pfl, lq); } pend = false; } while (0)
#define ATT_SELWIN(LATE_) do { constexpr bool late_c = LATE_; \
        int kc = st, vc = st; \
        bf16x8 pfl[4]; bool pend = false; int vprev = 0; \
        SEC_BEGIN; \
        { \
            m = NEG; l = 0.f; \
_Pragma("unroll") \
            for (int dt = 0; dt < 4; ++dt) \
_Pragma("unroll") \
                for (int i = 0; i < 16; ++i) O[dt][i] = 0.f; \
            unsigned long long rem = uni; \
            int j = __builtin_ctzll(rem); rem &= rem - 1; \
            for (;;) { \
                ATT_WAITBAR(); \
                const int jn = rem ? __builtin_ctzll(rem) : -1; \
                const int kn = kc ^ 1, vn = vc == 2 ? 0 : vc + 1; \
                if (jn >= 0) { rem &= rem - 1; tile_dma<true>(lds, kn, vn, ksb + (size_t)jn * 64 * 128, vsb + (size_t)jn * 64 * 128, goff, w); } \
                else tile_dma<true>(lds, kn, vn, kwb + (size_t)jlo * 64 * 128, vwb + (size_t)jlo * 64 * 128, goff, w); \
                const bool need = !(SKIP & 1) && ((wuni >> j) & 1ull); const bool lanesel = (mymask >> j) & 1ull; \
                ATT_STEP(1, need, 64 * j, j >= qi - 2, j == qi, lanesel); \
                if (jn < 0) break; \
                j = jn; \
            } \
            ATT_FLUSH(); \
            l = xsum32(l); \
            stage_out<true>(stg, O, l > 0.f ? g1 / l : 0.f, ln); \
        } \
        SEC_BEGIN; \
        { \
            m = NEG; l = 0.f; \
_Pragma("unroll") \
            for (int dt = 0; dt < 4; ++dt) \
_Pragma("unroll") \
                for (int i = 0; i < 16; ++i) O[dt][i] = 0.f; \
            for (int j = jlo; j <= qi; ++j) { \
                ATT_WAITBAR(); \
                const int kn = kc ^ 1, vn = vc == 2 ? 0 : vc + 1; \
                if (j + 1 <= qi) tile_dma<true>(lds, kn, vn, kwb + (size_t)(j + 1) * 64 * 128, vwb + (size_t)(j + 1) * 64 * 128, goff, w); \
                const bool masked = (j == qi) || (j == qi - 8); const bool need = !(SKIP & 2); \
                ATT_STEP(2, need, 64 * j, j >= qi - 2, masked, true); \
            } \
            ATT_FLUSH(); \
            l = xsum32(l); \
            stage_out<true>(stg, O, l > 0.f ? g2 / l : 0.f, ln); \
        } \
        } while (0)
        if (w >= 4) ATT_SELWIN(true); else ATT_SELWIN(false);
#undef ATT_SELWIN
#undef ATT_STEP
#undef ATT_FLUSH
        SEC_BEGIN;
        LDS_WAIT(); asm volatile("" ::: "memory");
#pragma unroll
        for (int i = 0; i < 8; ++i) {
            const int idx = ln + 64 * i, row = idx >> 4, ch = idx & 15;
            const u32x4 v = *(const LAS u32x4*)(stg + row * 272 + ch * 16);
            const int rql = row >> 2, rr = row & 3;
            *(u32x4*)(Oout + ((size_t)b * SEQ + t0 + 8 * w + rql) * DM + (g * 4 + rr) * 128 + ch * 8) = v;
        }
    }
}
#undef SEC_BEGIN
}


__device__ __forceinline__ void xcd_align(unsigned* cnt, unsigned nloc, int wave, int lane) {
    asm volatile("" ::: "memory"); __builtin_amdgcn_s_barrier(); asm volatile("" ::: "memory");
    if (wave == 0) {
        if (lane == 0) { (void)__hip_atomic_fetch_add(cnt, 1u, RLX_AGENT); }
        unsigned sp = 0u;
        while ((unsigned)__builtin_amdgcn_readfirstlane((int)__hip_atomic_load(cnt, RLX_AGENT)) < nloc) { __builtin_amdgcn_s_sleep(1); if (++sp > 40000u) break; }
    }
    asm volatile("" ::: "memory"); __builtin_amdgcn_s_barrier(); asm volatile("" ::: "memory");
}
namespace peer {
constexpr int LISTS = 0, IDXO = 90112, GATEO = 106496, SUO = 122880;
constexpr int XQO = 0, KEYO = 65536, HISTO = 81920, SXO = 86016;
static_assert(SUO + 16384 <= RING_BYTES && SXO + 256 + 2048 <= IDXO, "PEER tail LDS map");
__device__ __forceinline__ unsigned ford(float f) { const unsigned u = __float_as_uint(f); return (u & 0x80000000u) ? ~u : (u | 0x80000000u); }
__device__ __forceinline__ float finv(unsigned k) { return __uint_as_float((k & 0x80000000u) ? (k & 0x7fffffffu) : ~k); }
#define INS16(L, x) do { unsigned _x = (x); _Pragma("unroll") for (int _s = 0; _s < 16; ++_s) { const unsigned _h = L[_s] > _x ? L[_s] : _x; _x = L[_s] > _x ? _x : L[_s]; L[_s] = _h; } } while (0)

template <int TSKIP> __device__ __forceinline__ void tail_phase(const Frame& F, const Args& a, int layer, const bf16_t* SC, const float* H, const float* ssq, float* Ho, bf16_t* Hb, float* ssqo, float* outp, const unsigned char* Ub, const unsigned char* Vb, const float* Usc, const float* Vsc, unsigned* align_cnt, unsigned nloc) {
    LAS unsigned char* lds = F.lds; const int w = F.wave;
    LAS float* sc = (LAS float*)lds; LAS unsigned* lists = (LAS unsigned*)(lds + LISTS); LAS int* idxs = (LAS int*)(lds + IDXO); LAS float* gts = (LAS float*)(lds + GATEO); LAS float* sus = (LAS float*)(lds + SUO);
    const float* gain = a.ffn_norm + (size_t)layer * DM;
    for (int tile = blockIdx.x; tile < T / 32; tile += F.G) {
        const int t0 = tile * 32;
        int lane = F.lane; asm volatile("" : "+v"(lane)); const int tid = w * 64 + lane;
        unsigned L[16];
#pragma unroll
        for (int s = 0; s < 16; ++s) L[s] = 0u;
#define TK_CE(a_, b_) do { const unsigned h_ = (a_) > (b_) ? (a_) : (b_); (b_) = (a_) > (b_) ? (b_) : (a_); (a_) = h_; } while (0)
#define TK_SCAN() do { _Pragma("unroll") for (int g = 0; g < ((TSKIP & 4) ? 0 : 8); ++g) { unsigned K_[16]; \
            _Pragma("unroll") for (int i = 0; i < 8; ++i) { const unsigned dw = scw[tid * 65 + 8 * g + i]; \
                K_[2 * i] = (ford(bf_lo(dw)) & ~0x7Fu) | (unsigned)(127 - (16 * g + 2 * i)); K_[2 * i + 1] = (ford(bf_hi(dw)) & ~0x7Fu) | (unsigned)(127 - (16 * g + 2 * i + 1)); } \
            SORT_NET \
            _Pragma("unroll") for (int i = 0; i < 16; ++i) L[i] = L[i] > K_[15 - i] ? L[i] : K_[15 - i]; \
            BITONIC_NET } } while (0)
#define SORT_NET TK_CE(K_[0], K_[1]); TK_CE(K_[2], K_[3]); TK_CE(K_[4], K_[5]); TK_CE(K_[6], K_[7]); TK_CE(K_[8], K_[9]); TK_CE(K_[10], K_[11]); TK_CE(K_[12], K_[13]); TK_CE(K_[14], K_[15]); TK_CE(K_[0], K_[2]); TK_CE(K_[1], K_[3]); TK_CE(K_[4], K_[6]); TK_CE(K_[5], K_[7]); TK_CE(K_[8], K_[10]); TK_CE(K_[9], K_[11]); TK_CE(K_[12], K_[14]); TK_CE(K_[13], K_[15]); TK_CE(K_[1], K_[2]); TK_CE(K_[5], K_[6]); TK_CE(K_[9], K_[10]); TK_CE(K_[13], K_[14]); TK_CE(K_[0], K_[4]); TK_CE(K_[1], K_[5]); TK_CE(K_[2], K_[6]); TK_CE(K_[3], K_[7]); TK_CE(K_[8], K_[12]); TK_CE(K_[9], K_[13]); TK_CE(K_[10], K_[14]); TK_CE(K_[11], K_[15]); TK_CE(K_[2], K_[4]); TK_CE(K_[3], K_[5]); TK_CE(K_[10], K_[12]); TK_CE(K_[11], K_[13]); TK_CE(K_[1], K_[2]); TK_CE(K_[3], K_[4]); TK_CE(K_[5], K_[6]); TK_CE(K_[9], K_[10]); TK_CE(K_[11], K_[12]); TK_CE(K_[13], K_[14]); TK_CE(K_[0], K_[8]); TK_CE(K_[1], K_[9]); TK_CE(K_[2], K_[10]); TK_CE(K_[3], K_[11]); TK_CE(K_[4], K_[12]); TK_CE(K_[5], K_[13]); TK_CE(K_[6], K_[14]); TK_CE(K_[7], K_[15]); TK_CE(K_[4], K_[8]); TK_CE(K_[5], K_[9]); TK_CE(K_[6], K_[10]); TK_CE(K_[7], K_[11]); TK_CE(K_[2], K_[4]); TK_CE(K_[3], K_[5]); TK_CE(K_[6], K_[8]); TK_CE(K_[7], K_[9]); TK_CE(K_[10], K_[12]); TK_CE(K_[11], K_[13]); TK_CE(K_[1], K_[2]); TK_CE(K_[3], K_[4]); TK_CE(K_[5], K_[6]); TK_CE(K_[7], K_[8]); TK_CE(K_[9], K_[10]); TK_CE(K_[11], K_[12]); TK_CE(K_[13], K_[14]);
#define BITONIC_NET TK_CE(L[0], L[8]); TK_CE(L[1], L[9]); TK_CE(L[2], L[10]); TK_CE(L[3], L[11]); TK_CE(L[4], L[12]); TK_CE(L[5], L[13]); TK_CE(L[6], L[14]); TK_CE(L[7], L[15]); TK_CE(L[0], L[4]); TK_CE(L[1], L[5]); TK_CE(L[2], L[6]); TK_CE(L[3], L[7]); TK_CE(L[8], L[12]); TK_CE(L[9], L[13]); TK_CE(L[10], L[14]); TK_CE(L[11], L[15]); TK_CE(L[0], L[2]); TK_CE(L[1], L[3]); TK_CE(L[4], L[6]); TK_CE(L[5], L[7]); TK_CE(L[8], L[10]); TK_CE(L[9], L[11]); TK_CE(L[12], L[14]); TK_CE(L[13], L[15]); TK_CE(L[0], L[1]); TK_CE(L[2], L[3]); TK_CE(L[4], L[5]); TK_CE(L[6], L[7]); TK_CE(L[8], L[9]); TK_CE(L[10], L[11]); TK_CE(L[12], L[13]); TK_CE(L[14], L[15]);
        {
            LAS unsigned* scw = (LAS unsigned*)lds;
            u32x4 scv[16];
#pragma unroll
            for (int k = 0; k < 16; ++k) { const int f = tid + 512 * k, tok = f >> 8, hp = (f >> 4) & 15, q = f & 15; scv[k] = *(const u32x4*)(SC + (size_t)(t0 + tok) * DM + hp * 128 + 8 * q); }
            __syncthreads();
#pragma unroll
            for (int k = 0; k < 16; ++k) { const int f = tid + 512 * k, tok = f >> 8, hp = (f >> 4) & 15, q = f & 15; LAS unsigned* d = scw + (tok * 16 + hp) * 65 + 4 * q; d[0] = scv[k][0]; d[1] = scv[k][1]; d[2] = scv[k][2]; d[3] = scv[k][3]; }
            __syncthreads();
            TK_SCAN();
        }
#undef SORT_NET
#undef BITONIC_NET
#undef TK_CE
#undef TK_SCAN
        __syncthreads();
#pragma unroll
        for (int s = 0; s < 16; ++s) lists[tid * 17 + s] = L[s];
        __syncthreads();
        if (tid < 256 && !(TSKIP & 16)) {
            const int tok = tid >> 3, h = tid & 7; const int ta = (tok * 16 + h * 2) * 17, tb = ta + 17;
            float s1[16], s2[16];
#pragma unroll
            for (int s = 0; s < 16; ++s) { s1[s] = finv(lists[ta + s] & ~0x7Fu); s2[s] = finv(lists[tb + s] & ~0x7Fu); }
            unsigned C[16];
#pragma unroll
            for (int s = 0; s < 16; ++s) C[s] = 0u;
#pragma unroll
            for (int x = 0; x < 16; ++x)
#pragma unroll
                for (int y = 0; y < 16; ++y) if ((x + 1) * (y + 1) <= 16) { const unsigned key = (ford(s1[x] + s2[y]) & ~0xFFu) | (unsigned)(255 - (x * 16 + y)); INS16(C, key); }
            float ts[16]; float sum = 0.f; const float mx = finv(C[0] & ~0xFFu);
#pragma unroll
            for (int s = 0; s < 16; ++s) { ts[s] = __builtin_amdgcn_exp2f((finv(C[s] & ~0xFFu) - mx) * LOG2E); sum += ts[s]; }
            const float inv = 1.0f / sum;
#pragma unroll
            for (int s = 0; s < 16; ++s) { const int pos = 255 - (int)(C[s] & 0xFFu), x = pos >> 4, y = pos & 15;
                const int i1 = 127 - (int)(lists[ta + x] & 0x7Fu), i2 = 127 - (int)(lists[tb + y] & 0x7Fu);
                const int e = i1 * 128 + i2; idxs[tok * 128 + h * 16 + s] = e; gts[tok * 128 + h * 16 + s] = ts[s] * inv * Vsc[e] * 256.0f; sus[tok * 128 + h * 16 + s] = Usc[e]; }
        }
        __syncthreads();
        LAS unsigned char* xql = lds + XQO; LAS float* sxl = (LAS float*)(lds + SXO); LAS unsigned* keys = (LAS unsigned*)(lds + KEYO); LAS unsigned* hist = (LAS unsigned*)(lds + HISTO);
        f32x4 hpre[4][8]; float ppre[4];
#pragma unroll
        for (int it4 = 0; it4 < 4; ++it4) { const size_t t = (size_t)t0 + w + 8 * it4;
#pragma unroll
            for (int m = 0; m < 8; ++m) hpre[it4][m] = *(const f32x4*)(H + t * DM + 256 * m + 4 * lane);
            ppre[it4] = lane < 32 ? ssq[t * 32 + lane] : 0.f; }
        f32x4 gpre[8];
#pragma unroll
        for (int m = 0; m < 8; ++m) gpre[m] = *(const f32x4*)(gain + 256 * m + 4 * lane);
#pragma unroll
        for (int it4 = 0; it4 < ((TSKIP & 8) ? 0 : 4); ++it4) {
            const int tl = w + 8 * it4;
            int ln = lane; asm volatile("" : "+v"(ln));
            float pss = ppre[it4]; pss = wave_sum(pss);
            const float rstd = rsqrtf(pss * (1.0f / DM) + EPS);
            {
                float xv[2][16]; float am = 0.f;
#pragma unroll
                for (int j = 0; j < 2; ++j)
#pragma unroll
                    for (int i = 0; i < 4; ++i) { const f32x4 h4 = hpre[it4][i + 4 * j], g4 = gpre[i + 4 * j];
#pragma unroll
                        for (int c = 0; c < 4; ++c) { xv[j][4 * i + c] = h4[c] * rstd * g4[c]; am = __builtin_fmaxf(am, __builtin_fabsf(xv[j][4 * i + c])); } }
                am = __builtin_fmaxf(am, dpp_f<0xB1>(am)); am = __builtin_fmaxf(am, dpp_f<0x4E>(am)); am = __builtin_fmaxf(am, dpp_f<0x141>(am)); am = __builtin_fmaxf(am, dpp_f<0x140>(am));
                am = __builtin_fmaxf(__builtin_fmaxf(__builtin_bit_cast(float, __builtin_amdgcn_readlane(__builtin_bit_cast(int, am), 0)), __builtin_bit_cast(float, __builtin_amdgcn_readlane(__builtin_bit_cast(int, am), 16))),
                                     __builtin_fmaxf(__builtin_bit_cast(float, __builtin_amdgcn_readlane(__builtin_bit_cast(int, am), 32)), __builtin_bit_cast(float, __builtin_amdgcn_readlane(__builtin_bit_cast(int, am), 48))));
                const float qs = am > 0.f ? 119.0f / am : 1.0f;
                if (ln == 0) sxl[tl] = am > 0.f ? am * (1.0f / 119.0f) : 1.0f;
                float sx = 0.f; u32x4 ph, pl;
#pragma unroll
                for (int i = 0; i < 4; ++i) { unsigned wh = 0u, wl = 0u;
#pragma unroll
                    for (int c = 0; c < 4; ++c) { const int x0 = (int)__builtin_rintf(xv[0][4 * i + c] * qs), x1 = (int)__builtin_rintf(xv[1][4 * i + c] * qs); sx += (float)(x0 + x1);
                        const int l0 = ((x0 + 8) & 15) - 8, l1 = ((x1 + 8) & 15) - 8, h0 = (x0 - l0) >> 4, h1 = (x1 - l1) >> 4;
                        wh |= (((unsigned)h0 & 15u) | (((unsigned)h1 & 15u) << 4)) << (8 * c); wl |= (((unsigned)l0 & 15u) | (((unsigned)l1 & 15u) << 4)) << (8 * c); }
                    ph[i] = wh; pl[i] = wl; }
                *(LAS u32x4*)(xql + tl * 2048 + 16 * ln) = ph; *(LAS u32x4*)(xql + tl * 2048 + 1024 + 16 * ln) = pl;
                sx = wave_sum(sx);
                if (ln == 0) sxl[32 + tl] = 0.5f * sx;
            }
        }
        { int td = tid; asm volatile("" : "+v"(td)); hist[td] = 0u; }
        __syncthreads();
        {
            int td = tid; asm volatile("" : "+v"(td));
            unsigned mykey[8];
#pragma unroll
            for (int q = 0; q < 8; ++q) { const int pid = td + 512 * q; const unsigned e = (unsigned)idxs[pid]; mykey[q] = (e << 12) | (unsigned)pid; (void)__hip_atomic_fetch_add(hist + (e >> 6), 1u, __ATOMIC_RELAXED, __HIP_MEMORY_SCOPE_WORKGROUP); }
            __syncthreads();
            if (w == 0) {
                int lane_s = lane; asm volatile("" : "+v"(lane_s));
                unsigned c[4]; unsigned s4 = 0u;
#pragma unroll
                for (int k = 0; k < 4; ++k) { c[k] = hist[4 * lane_s + k]; s4 += c[k]; }
                unsigned inc = s4;
#pragma unroll
                for (int o = 1; o < 64; o <<= 1) { const unsigned up = __shfl_up(inc, o); inc += lane_s >= o ? up : 0u; }
                unsigned ex = inc - s4;
#pragma unroll
                for (int k = 0; k < 4; ++k) { hist[256 + 4 * lane_s + k] = ex; ex += c[k]; }
            }
            __syncthreads();
#pragma unroll
            for (int q = 0; q < 8; ++q) { const unsigned pos = __hip_atomic_fetch_add(hist + 256 + (mykey[q] >> 18), 1u, __ATOMIC_RELAXED, __HIP_MEMORY_SCOPE_WORKGROUP); keys[(pos & 7u) * 512u + (pos >> 3)] = mykey[q]; }
            __syncthreads();
        }
        {
            int ln = lane; asm volatile("" : "+v"(ln));
            const int c16 = (ln & 15) * 16;
            const LAS unsigned* kw = keys + w * 512 + (ln >> 4);
            const unsigned char* ubase = Ub + c16;
#define CO_KEYS(kv, b_) do { kv[0] = kw[(b_) * 8]; kv[1] = kw[(b_) * 8 + 4]; } while (0)
#define CO_LOAD(buf, kreg, kv) do { _Pragma("unroll") for (int s_ = 0; s_ < 2; ++s_) { const unsigned key = kv[s_]; kreg[s_] = key; \
        const unsigned char* ur = ((PROBE_UC && rep_ == 0) ? Vb + c16 : ubase) + (size_t)((PROBE_UF && rep_ == 0) ? (key >> 24) : (key >> 12)) * EROW; \
        _Pragma("unroll") for (int i = 0; i < 4; ++i) buf[s_][i] = *(const u32x4*)(ur + 256 * i); } } while (0)
#define CO_COMP(buf, kreg) do { _Pragma("unroll") for (int s_ = 0; s_ < 2; ++s_) { \
        const unsigned key = kreg[s_]; const int tok = (int)((key >> 7) & 31u), pid = (int)(key & 4095u); u32x4 xh_[4], xl_[4]; \
        _Pragma("unroll") for (int i = 0; i < 4; ++i) { xh_[i] = *(const LAS u32x4*)(xql + tok * 2048 + c16 + 256 * i); xl_[i] = *(const LAS u32x4*)(xql + tok * 2048 + 1024 + c16 + 256 * i); } \
        const float t_g = gts[pid], t_s = sus[pid], t_x = sxl[tok], t_o = sxl[32 + tok]; \
        __builtin_amdgcn_sched_barrier(0); \
        int di = 0, dl_ = 0; \
        _Pragma("unroll") for (int i = 0; i < 4; ++i) _Pragma("unroll") for (int k = 0; k < 4; ++k) { const int w_ = (int)buf[s_][i][k]; di = __builtin_amdgcn_sdot8(w_, (int)xh_[i][k], di, false); dl_ = __builtin_amdgcn_sdot8(w_, (int)xl_[i][k], dl_, false); }     \
        const float ev = row_sum16((float)(di * 16 + dl_)); \
        if ((ln & 15) == 0) { const float act_ = t_g * gelu_tanh((ev + t_o) * (t_s * t_x)); if (PROBE_U && rep_ == 0) ((LAS float*)(lds + SXO + 256))[pid & 511] = act_; else sus[pid] = act_; } \
        if (s_ == 0) asm volatile("" : "+v"(buf[1][0]), "+v"(buf[1][1]), "+v"(buf[1][2]), "+v"(buf[1][3])); } \
        __builtin_amdgcn_sched_barrier(0); } while (0)
            if (!(TSKIP & 1)) for (int rep_ = 0; rep_ < (PROBE_U ? 2 : 1); ++rep_) {
            u32x4 A[2][4], B[2][4]; unsigned kvA[2], kvB[2], kA[2], kB[2];
            CO_KEYS(kvA, 0); CO_KEYS(kvB, 1);
            CO_LOAD(A, kA, kvA); CO_KEYS(kvA, 2);
            for (int b = 0; b < 62; b += 2) {
                if (align_cnt && (b & 15) == 0) xcd_align(align_cnt + (b >> 3) * 64, nloc, w, lane);
                CO_LOAD(B, kB, kvB); CO_KEYS(kvB, b + 3); __builtin_amdgcn_sched_barrier(0);
                CO_COMP(A, kA);
                CO_LOAD(A, kA, kvA); CO_KEYS(kvA, (b + 4) & 63); __builtin_amdgcn_sched_barrier(0);
                CO_COMP(B, kB);
            }
            CO_LOAD(B, kB, kvB); __builtin_amdgcn_sched_barrier(0);
            CO_COMP(A, kA); __builtin_amdgcn_sched_barrier(0);
            CO_COMP(B, kB);
            }
#undef CO_KEYS
#undef CO_LOAD
#undef CO_COMP
        }
        __syncthreads();
        LAS unsigned* keysv = (LAS unsigned*)(lds + XQO);
        if (!(TSKIP & 32)) for (int s4 = 0; s4 < 4; ++s4) {
            int ln = lane; asm volatile("" : "+v"(ln));
            unsigned kq[2]; int pos[2];
#pragma unroll
            for (int q = 0; q < 2; ++q) { const int pid = (w + 8 * s4) * 128 + ln + 64 * q; kq[q] = ((unsigned)idxs[pid] << 12) | (unsigned)pid; pos[q] = 0; }
            int prefix = 0;
            for (int k = 0; k < 16; ++k) {
                int base = prefix;
#pragma unroll
                for (int q = 0; q < 2; ++q) { const bool hit = (int)(kq[q] >> 22) == k; const unsigned long long m = __ballot(hit);
                    const int r = (int)__builtin_amdgcn_mbcnt_hi((unsigned)(m >> 32), __builtin_amdgcn_mbcnt_lo((unsigned)m, 0u)); pos[q] = hit ? base + r : pos[q]; base += __popcll(m); }
                prefix = base;
            }
#pragma unroll
            for (int q = 0; q < 2; ++q) keysv[512 * w + 128 * s4 + pos[q]] = kq[q];
        }
        LDS_WAIT(); asm volatile("" ::: "memory");
        for (int pr = 0; pr < 2; ++pr) {
            int ln = lane; asm volatile("" : "+v"(ln));
            h16x2 out[2][16];
#pragma unroll
            for (int sl = 0; sl < 2; ++sl)
#pragma unroll
                for (int i = 0; i < 16; ++i) out[sl][i] = (h16x2){(_Float16)0.f, (_Float16)0.f};
            const LAS unsigned* ka = keysv + 512 * w + 256 * pr;
            f32x4 hres[2][8];
#pragma unroll
            for (int sl = 0; sl < 2; ++sl)
#pragma unroll
                for (int m = 0; m < 8; ++m) hres[sl][m] = *(const f32x4*)(H + ((size_t)t0 + w + 8 * (2 * pr + sl)) * DM + 256 * m + 4 * ln);
#define PV_KEYS(kv, b_) do { kv[0] = *(const LAS u32x4*)(ka + (b_) * 4); kv[1] = *(const LAS u32x4*)(ka + 128 + (b_) * 4); } while (0)
#define PV_LOAD(buf, wv, kv) do { _Pragma("unroll") for (int rr = 0; rr < 8; ++rr) { const unsigned key = (unsigned)__builtin_amdgcn_readfirstlane((int)kv[rr >> 2][rr & 3]); \
        buf[rr] = *(const u32x4*)(Vb + (size_t)((PROBE_VF && rep_ == 0) ? (key >> 24) : (key >> 12)) * EROW + 16 * ln); wv[rr] = sus[key & 4095u]; } } while (0)
#define PEER_ACC(buf_, sl_, wgt_) do { const _Float16 wh_ = (_Float16)(wgt_); const h16x2 w2 = (h16x2){wh_, wh_}; _Pragma("unroll") for (int i = 0; i < 4; ++i) { \
        out[sl_][4 * i + 0] = __builtin_elementwise_fma(w2, __builtin_bit_cast(h16x2, __builtin_amdgcn_cvt_scalef32_pk_f16_fp4(buf_[i], 1.0f, 0)), out[sl_][4 * i + 0]); out[sl_][4 * i + 1] = __builtin_elementwise_fma(w2, __builtin_bit_cast(h16x2, __builtin_amdgcn_cvt_scalef32_pk_f16_fp4(buf_[i], 1.0f, 1)), out[sl_][4 * i + 1]); \
        out[sl_][4 * i + 2] = __builtin_elementwise_fma(w2, __builtin_bit_cast(h16x2, __builtin_amdgcn_cvt_scalef32_pk_f16_fp4(buf_[i], 1.0f, 2)), out[sl_][4 * i + 2]); out[sl_][4 * i + 3] = __builtin_elementwise_fma(w2, __builtin_bit_cast(h16x2, __builtin_amdgcn_cvt_scalef32_pk_f16_fp4(buf_[i], 1.0f, 3)), out[sl_][4 * i + 3]); } } while (0)
#define PV_COMP(buf, wv) do { _Pragma("unroll") for (int rr = 0; rr < 8; ++rr) { if (rr < 4) PEER_ACC(buf[rr], 0, wv[rr]); else PEER_ACC(buf[rr], 1, wv[rr]); \
            if (rr < 7) asm volatile("" : "+v"(buf[rr + 1 < 8 ? rr + 1 : 7])); } } while (0)
            if (!(TSKIP & 2)) for (int rep_ = 0; rep_ < (PROBE_V ? 2 : 1); ++rep_) {
                if (PROBE_V && rep_ == 1) {
#pragma unroll
                    for (int sl = 0; sl < 2; ++sl)
#pragma unroll
                        for (int i = 0; i < 16; ++i) { asm volatile("" :: "v"(out[sl][i])); out[sl][i] = (h16x2){(_Float16)0.f, (_Float16)0.f}; }
                }
                u32x4 A[8], B[8], kvA[2], kvB[2]; float wA[8], wB[8];
                PV_KEYS(kvA, 0); PV_KEYS(kvB, 1);
                PV_LOAD(A, wA, kvA); PV_KEYS(kvA, 2);
                for (int b = 0; b < 30; b += 2) {
                    if (align_cnt && (b & 15) == 0) xcd_align(align_cnt + (8 + pr * 4 + (b >> 3)) * 64, nloc, w, lane);
                    PV_LOAD(B, wB, kvB); PV_KEYS(kvB, b + 3); __builtin_amdgcn_sched_barrier(0);
                    PV_COMP(A, wA);
                    PV_LOAD(A, wA, kvA); PV_KEYS(kvA, (b + 4) & 31); __builtin_amdgcn_sched_barrier(0);
                    PV_COMP(B, wB);
                }
                PV_LOAD(B, wB, kvB); __builtin_amdgcn_sched_barrier(0);
                PV_COMP(A, wA); __builtin_amdgcn_sched_barrier(0);
                PV_COMP(B, wB);
            }
#undef PV_KEYS
#undef PV_LOAD
#undef PEER_ACC
#undef PV_COMP
#pragma unroll
            for (int sl = 0; sl < 2; ++sl) {
                const size_t t = (size_t)t0 + w + 8 * (2 * pr + sl);
                float s2 = 0.f; float of[2][16];
#pragma unroll
                for (int j = 0; j < 2; ++j)
#pragma unroll
                    for (int i = 0; i < 4; ++i) { const f32x4 h4 = hres[sl][i + 4 * j];
#pragma unroll
                        for (int c = 0; c < 4; ++c) { const float v_ = (float)out[sl][4 * i + c][j] * (1.0f / 256.0f) + h4[c]; of[j][4 * i + c] = v_; s2 += v_ * v_; } }
                s2 = wave_sum(s2);
                if (layer == DEPTH - 1) {
                    const float r2 = rsqrtf(s2 * (1.0f / DM) + EPS);
#pragma unroll
                    for (int j = 0; j < 2; ++j)
#pragma unroll
                        for (int i = 0; i < 4; ++i) { const int e0 = 256 * (i + 4 * j) + 4 * ln; const f32x4 g4 = *(const f32x4*)(a.final_norm + e0); f32x4 o;
#pragma unroll
                            for (int c = 0; c < 4; ++c) o[c] = of[j][4 * i + c] * r2 * g4[c];
                            *(f32x4*)(outp + t * DM + e0) = o; }
                } else {
#pragma unroll
                    for (int j = 0; j < 2; ++j) {
#pragma unroll
                        for (int i = 0; i < 4; ++i) { const int e0 = 256 * (i + 4 * j) + 4 * ln; f32x4 o;
#pragma unroll
                            for (int c = 0; c < 4; ++c) o[c] = of[j][4 * i + c];
                            *(f32x4*)(Ho + t * DM + e0) = o; }
#pragma unroll
                        for (int i = 0; i < 4; ++i) { const int e0 = 256 * (i + 4 * j) + 4 * ln; u32x2 o;
                            o.x = cvtpk(of[j][4 * i], of[j][4 * i + 1]); o.y = cvtpk(of[j][4 * i + 2], of[j][4 * i + 3]);
                            *(u32x2*)(Hb + t * DM + e0) = o; }
                    }
                    if (ln < 32) ssqo[t * 32 + ln] = ln == 0 ? s2 : 0.f;
                }
            }
        }
    }
}
}

constexpr int CW_BAR = 4096, CW_ALIGN = 32768;
static_assert((CW_ALIGN + DEPTH * 16 * 16 * 64) * 4 <= (int)CTL_ZERO_BYTES, "CTL words inside the memset region");
constexpr int N_PHASES = 2 + 8 * DEPTH;

__global__ void __launch_bounds__(512, 2) mk_fwd(Args args) {
    extern __shared__ __attribute__((aligned(16))) unsigned char lds_raw[];
    Frame F;
    F.lds = (LAS unsigned char*)lds_raw;
    F.tid = threadIdx.x; F.lane = F.tid & 63; F.wave = __builtin_amdgcn_readfirstlane(F.tid >> 6);
    F.G = gridDim.x; { const int bx = blockIdx.x; F.vcu = (F.G % 8 == 0) ? (bx % 8) * (F.G / 8) + bx / 8 : bx; }
    volatile LAS unsigned* MISC = (volatile LAS unsigned*)(F.lds + MISC_OFF);
    if (F.tid < 32) MISC[F.tid] = 0u;
    __syncthreads();
    XcdBarrier bar; bar.bar = (unsigned*)(args.ws + WS_CTL) + CW_BAR; bar.x = 0; bar.st = nullptr;
    if (MK_N_LAUNCHES == 1) bar = xcd_barrier_post((unsigned*)(args.ws + WS_CTL) + CW_BAR, MISC + 8);
    const int lo = args.ph_lo, hi = args.ph_hi;
#ifndef EN_MASK
#define EN_MASK 0xFFFF
#endif
#define EN(b) ((EN_MASK >> (b)) & 1)
#define PROBE(b) ((PROBE_MASK >> (b)) & 1)
#ifndef PROBE_SKIP
#define PROBE_SKIP 0
#endif
#define IN(k) (lo <= (k) && (k) < hi)
#define SEAM(k) do { if ((k) + 1 < hi) xcd_barrier(bar, F.wave); } while (0)

#define PH_BEGIN Frame P = F; { const int l_ = fresh_lane(); P.lane = l_; P.tid = F.wave * 64 + l_; } const __attribute__((address_space(4))) Args* kp_ = (const __attribute__((address_space(4))) Args*)__builtin_amdgcn_kernarg_segment_ptr(); asm volatile("" : "+s"(kp_)); const Args a = *(const Args*)kp_; \
    unsigned char* ws = a.ws; \
    float* H = (float*)(ws + WS_H); bf16_t* Hb = (bf16_t*)(ws + WS_HB); float* ssq = (float*)(ws + WS_SSQ); const LAS float* rs = (const LAS float*)(F.lds + RS_OFF); (void)H; (void)Hb; (void)ssq; (void)rs

    if (EN(0) && IN(0)) { PH_BEGIN; if (PROBE(0)) { p0_prologue(P, a); __syncthreads(); } p0_prologue(P, a); SEAM(0); }
    if (EN(1) && IN(1)) { PH_BEGIN;
        pg8::FoldOrder S{(const char*)(ws + WS_KEYSPAD), (const char*)(ws + WS_WQN), F.G, (int)blockIdx.x};
        pg8::EpiBf16 E{(bf16_t*)(ws + WS_WPT), DM};
        pg8::gemm_phase<256, DM, 256>(F.lds, P.tid, S, E);
    }
    for (int L = 0; L < DEPTH; ++L) {
        const int pb = 2 + 8 * L, j = L >> 1;

        if ((L & 1) == 0) {
            if (EN(2) && IN(pb + 0)) { PH_BEGIN;
                pg8::PlainOrder S; S.init(Hb, DM, (bf16_t*)(ws + WS_WCIN) + (size_t)j * NCIN * DM, DM, T, NCIN, F.G, (int)blockIdx.x);
                fill_rstd(P, S, ssq);
                pg8::EpiConvIn E{(bf16_t*)(ws + WS_BG), (bf16_t*)(ws + WS_Z), rs};
                if (PROBE(2)) { pg8::gemm_phase<DM, DM, DM>(F.lds, P.tid, S, E); __syncthreads(); }
                pg8::gemm_phase<DM, DM, DM>(F.lds, P.tid, S, E);
                SEAM(pb + 0);
            }
            if (EN(3) && IN(pb + 1)) { PH_BEGIN; if (PROBE(3)) { conv_gate_phase(P, (const bf16_t*)(ws + WS_BG), (const bf16_t*)(ws + WS_Z), a.conv_kernel + (size_t)j * 3 * DM, (bf16_t*)(ws + WS_Y)); __syncthreads(); } conv_gate_phase(P, (const bf16_t*)(ws + WS_BG), (const bf16_t*)(ws + WS_Z), a.conv_kernel + (size_t)j * 3 * DM, (bf16_t*)(ws + WS_Y)); SEAM(pb + 1); }
            if (EN(4) && IN(pb + 4)) { PH_BEGIN;
                pg8::PlainOrder S; S.init((bf16_t*)(ws + WS_Y), DM, (bf16_t*)(ws + WS_WCOUT) + (size_t)j * DM * DM, DM, T, DM, F.G, (int)blockIdx.x);
                pg8::EpiResid E{L == 0 ? a.x : (const float*)H, H, Hb, ssq};
                pg8::gemm_phase<DM, DM, DM>(F.lds, P.tid, S, E);
                SEAM(pb + 4);
            }
        } else {
            if (EN(5) && IN(pb + 0)) { PH_BEGIN;
                pg8::PlainOrder S; S.init(Hb, DM, (bf16_t*)(ws + WS_WNIN) + (size_t)j * NNPAD * DM, DM, T, NNPAD, F.G, (int)blockIdx.x);
                fill_rstd(P, S, ssq);
                pg8::EpiNsaIn E{(bf16_t*)(ws + WS_BG), (bf16_t*)(ws + WS_KV), (float*)(ws + WS_GATES), rs};
                if (PROBE(5)) { pg8::gemm_phase<DM, DM, DM>(F.lds, P.tid, S, E); __syncthreads(); }
                const int nbusy = ((T / 256) * (NNPAD / 256)) % F.G, lay = L == 1 ? 2 : 3;
                if (nbusy == 0) convert_expert_rows(a, ws, P.lane, lay * NEXP, lay * NEXP + CONV_SPLIT, (int)blockIdx.x * 8 + F.wave, F.G * 8, 1);
                pg8::gemm_phase<DM, DM, DM>(F.lds, P.tid, S, E);
                if (nbusy != 0 && (int)blockIdx.x >= nbusy) convert_expert_rows(a, ws, P.lane, lay * NEXP, lay * NEXP + CONV_SPLIT, ((int)blockIdx.x - nbusy) * 8 + F.wave, (F.G - nbusy) * 8, 1);
                SEAM(pb + 0);
            }
            if (EN(6) && IN(pb + 1)) { PH_BEGIN;
                pg8::CmpOrder S{(const char*)(ws + WS_KV), (const char*)((bf16_t*)(ws + WS_WC1) + (size_t)j * 2 * 256 * 4096), F.G, (int)blockIdx.x};
                pg8::EpiSlab E{(bf16_t*)(ws + WS_SLAB)};
                if (PROBE(6)) { pg8::gemm_phase<2048, 4096, 512>(F.lds, P.tid, S, E); __syncthreads(); }
                pg8::gemm_phase<2048, 4096, 512>(F.lds, P.tid, S, E);
                { const int lay2 = L == 1 ? 2 : 3;
                  if (F.G > 128) { if ((int)blockIdx.x >= 128) convert_expert_rows(a, ws, P.lane, lay2 * NEXP + CONV_SPLIT, (lay2 + 1) * NEXP, ((int)blockIdx.x - 128) * 8 + F.wave, (F.G - 128) * 8, 1); }
                  else convert_expert_rows(a, ws, P.lane, lay2 * NEXP + CONV_SPLIT, (lay2 + 1) * NEXP, (int)blockIdx.x * 8 + F.wave, F.G * 8, 1); }
                SEAM(pb + 1);
            }
            if (EN(7) && IN(pb + 2)) { PH_BEGIN;
                if (PROBE(7)) { cmp_finalize_phase(P, (const bf16_t*)(ws + WS_SLAB), (const float*)(ws + WS_BIAS1P) + (size_t)j * 2 * 64 * 256, a.cmp_w2_k + (size_t)j * 256 * 128, a.cmp_w2_v + (size_t)j * 256 * 128,
                                   (bf16_t*)(ws + WS_KC), (bf16_t*)(ws + WS_VC)); __syncthreads(); }
                cmp_finalize_phase(P, (const bf16_t*)(ws + WS_SLAB), (const float*)(ws + WS_BIAS1P) + (size_t)j * 2 * 64 * 256, a.cmp_w2_k + (size_t)j * 256 * 128, a.cmp_w2_v + (size_t)j * 256 * 128,
                                   (bf16_t*)(ws + WS_KC), (bf16_t*)(ws + WS_VC));
                SEAM(pb + 2);
            }
            if (EN(8) && IN(pb + 3)) { PH_BEGIN;
                if (PROBE(8)) { att::attn_phase<PROBE_SKIP>(P, (const bf16_t*)(ws + WS_BG), (const bf16_t*)(ws + WS_KV), (const bf16_t*)(ws + WS_KC), (const bf16_t*)(ws + WS_VC), (const float*)(ws + WS_GATES), a.rel_bias, (bf16_t*)(ws + WS_O)); __syncthreads(); }
                att::attn_phase<0>(P, (const bf16_t*)(ws + WS_BG), (const bf16_t*)(ws + WS_KV), (const bf16_t*)(ws + WS_KC), (const bf16_t*)(ws + WS_VC), (const float*)(ws + WS_GATES), a.rel_bias, (bf16_t*)(ws + WS_O));
                SEAM(pb + 3);
            }
            if (EN(9) && IN(pb + 4)) { PH_BEGIN;
                pg8::PlainOrder S; S.init((bf16_t*)(ws + WS_O), DM, (bf16_t*)(ws + WS_WNOUT) + (size_t)j * DM * DM, DM, T, DM, F.G, (int)blockIdx.x);
                pg8::EpiResid E{L == 0 ? a.x : (const float*)H, H, Hb, ssq};
                pg8::gemm_phase<DM, DM, DM>(F.lds, P.tid, S, E);
                SEAM(pb + 4);
            }
        }
        if (EN(10) && IN(pb + 5)) { PH_BEGIN;
            pg8::PlainOrder S; S.init(Hb, DM, (bf16_t*)(ws + WS_WPT) + (size_t)L * DM * DM, DM, T, DM, F.G, (int)blockIdx.x);
            fill_rstd(P, S, ssq);
            pg8::EpiScores E{(bf16_t*)(ws + WS_SC), rs};
            if (PROBE(10)) { pg8::gemm_phase<DM, DM, DM>(F.lds, P.tid, S, E); __syncthreads(); }
            pg8::gemm_phase<DM, DM, DM>(F.lds, P.tid, S, E);
            SEAM(pb + 5);
        }
        if (EN(11) && IN(pb + 6)) { PH_BEGIN;
            if (PROBE(11)) { peer::tail_phase<PROBE_TSKIP>(P, a, L, (const bf16_t*)(ws + WS_SC), H, ssq, (float*)(ws + WS_SLAB), (bf16_t*)(ws + WS_O), (float*)(ws + WS_BG), (float*)(ws + WS_SLAB), ws + WS_UB + (size_t)L * NEXP * EROW, ws + WS_VB + (size_t)L * NEXP * EROW, (const float*)(ws + WS_USC) + (size_t)L * NEXP, (const float*)(ws + WS_VSC) + (size_t)L * NEXP, nullptr, 1u); __syncthreads(); }
            peer::tail_phase<0>(P, a, L, (const bf16_t*)(ws + WS_SC), H, ssq, H, Hb, ssq, a.out, ws + WS_UB + (size_t)L * NEXP * EROW, ws + WS_VB + (size_t)L * NEXP * EROW, (const float*)(ws + WS_USC) + (size_t)L * NEXP, (const float*)(ws + WS_VSC) + (size_t)L * NEXP,
                             MK_N_LAUNCHES == 1 ? (unsigned*)(ws + WS_CTL) + CW_ALIGN + ((L * 16 + (int)xb_xcc_id()) * 16) * 64 : nullptr, MISC[8]);
            SEAM(pb + 6);
        }
    }
#undef IN
#undef EN
#undef SEAM
#undef PH_BEGIN
}

extern "C" void kernel_launch(void* const* d_in, const int* in_sizes, int n_in, void* d_out, int out_size, void* d_ws, size_t ws_size, hipStream_t stream) {
    static int grid = 0;
    if (grid == 0) {
        if (n_in != 20 || out_size != T * DM || ws_size < WS_END) { fprintf(stderr, "kernel_launch: unexpected shapes (n_in %d out %d ws %zu)\n", n_in, out_size, ws_size); grid = -1; return; }
        int dev = 0, cus = 0, per_cu = 0;
        if (hipGetDevice(&dev) != hipSuccess || hipDeviceGetAttribute(&cus, hipDeviceAttributeMultiprocessorCount, dev) != hipSuccess) { grid = -1; return; }
        if (hipFuncSetAttribute((const void*)mk_fwd, hipFuncAttributeMaxDynamicSharedMemorySize, LDS_BYTES) != hipSuccess) { fprintf(stderr, "kernel_launch: hipFuncSetAttribute failed\n"); grid = -1; return; }
        if (hipOccupancyMaxActiveBlocksPerMultiprocessor(&per_cu, (const void*)mk_fwd, 512, LDS_BYTES) != hipSuccess || per_cu < 1) fprintf(stderr, "kernel_launch: occupancy query reports %d\n", per_cu);
        (void)hipGetLastError();
        grid = cus;
    }
    if (grid < 0) return;
    (void)hipMemsetAsync((char*)d_ws + WS_CTL, 0, CTL_ZERO_BYTES, stream);
    Args a{};
    a.x = (const float*)d_in[0]; a.rel_bias = (const float*)d_in[1]; a.mix_norm = (const float*)d_in[2]; a.ffn_norm = (const float*)d_in[3]; a.final_norm = (const float*)d_in[4];
    a.conv_w_in = (const float*)d_in[5]; a.conv_kernel = (const float*)d_in[6]; a.conv_w_out = (const float*)d_in[7];
    a.nsa_w_in = (const float*)d_in[8]; a.cmp_pos_k = (const float*)d_in[9]; a.cmp_pos_v = (const float*)d_in[10]; a.cmp_w1_k = (const float*)d_in[11]; a.cmp_w2_k = (const float*)d_in[12];
    a.cmp_w1_v = (const float*)d_in[13]; a.cmp_w2_v = (const float*)d_in[14]; a.nsa_w_out = (const float*)d_in[15];
    a.peer_w_q = (const float*)d_in[16]; a.peer_sub_keys = (const float*)d_in[17]; a.peer_u = (const float*)d_in[18]; a.peer_v = (const float*)d_in[19];
    a.out = (float*)d_out; a.ws = (unsigned char*)d_ws;
    if (MK_N_LAUNCHES == 1) {
        a.ph_lo = 0; a.ph_hi = N_PHASES; a.li = 0;
        hipLaunchKernelGGL(mk_fwd, dim3(grid), dim3(512), LDS_BYTES, stream, a);
    } else {
        for (int p = 0; p < N_PHASES; ++p) {
            const int s = p < 2 ? -1 : (p - 2) & 7, L = p < 2 ? 0 : (p - 2) >> 3;
            if (s == 7) continue; if ((L & 1) == 0 && (s == 2 || s == 3)) continue;
            a.ph_lo = p; a.ph_hi = p + 1; a.li = p;
            hipLaunchKernelGGL(mk_fwd, dim3(grid), dim3(512), LDS_BYTES, stream, a);
        }
    }
}
```

```cpp
#include <hip/hip_runtime.h>
#include <cstdio>
#include <cstdint>

#ifndef MK_N_LAUNCHES
#define MK_N_LAUNCHES 1
#endif

#ifndef PROBE_MASK
#define PROBE_MASK 0
#endif
#ifndef PROBE_TSKIP
#define PROBE_TSKIP 0
#endif
#define PROBE_U ((PROBE_MASK >> 14) & 1)
#define PROBE_V ((PROBE_MASK >> 15) & 1)
#define PROBE_UF ((PROBE_MASK >> 16) & 1)
#define PROBE_VF ((PROBE_MASK >> 17) & 1)
#define PROBE_UC ((PROBE_MASK >> 18) & 1)
#define LAS __attribute__((address_space(3)))
#define GAS __attribute__((address_space(1)))
typedef unsigned short bf16_t;
typedef short bf16x8 __attribute__((ext_vector_type(8)));
typedef short s16x4 __attribute__((ext_vector_type(4)));
typedef short v4i16_t __attribute__((ext_vector_type(4)));
typedef float f32x2 __attribute__((ext_vector_type(2)));
typedef _Float16 h16x2 __attribute__((ext_vector_type(2)));
typedef float f32x4 __attribute__((ext_vector_type(4)));
typedef float f32x16 __attribute__((ext_vector_type(16)));
typedef unsigned u32x2 __attribute__((ext_vector_type(2)));
typedef unsigned u32x4 __attribute__((ext_vector_type(4)));
typedef __bf16 bf16x2_t __attribute__((ext_vector_type(2)));
typedef GAS unsigned gu32;

constexpr int DM = 2048, SEQ = 4096, NB = 2, T = NB * SEQ, DEPTH = 4;
constexpr int NCIN = 6144, NNIN = 5168, NNPAD = 5376;
constexpr int NEXP = 16384, EROW = 1024, CONV_SPLIT = 11520  ;
constexpr float EPS = 1e-6f;
constexpr float LOG2E = 1.4426950408889634f;
constexpr float QSCALE = 0.08838834764831845f * LOG2E;

constexpr size_t MiB = 1u << 20;
constexpr size_t WS_CTL = 0, CTL_ZERO_BYTES = 1 * MiB;
constexpr size_t WS_SSQ = 1 * MiB;
constexpr size_t WS_GATES = 2 * MiB;
constexpr size_t WS_BIAS1P = 4 * MiB;
constexpr size_t WS_KC = 5 * MiB;
constexpr size_t WS_VC = 5 * MiB + 512 * 1024;
constexpr size_t WS_KEYSPAD = 6 * MiB;
constexpr size_t WS_WCIN = 16 * MiB;
constexpr size_t WS_WCOUT = 64 * MiB;
constexpr size_t WS_WNIN = 80 * MiB;
constexpr size_t WS_WNOUT = 122 * MiB;
constexpr size_t WS_WQN = 138 * MiB;
constexpr size_t WS_WPT = 170 * MiB;
constexpr size_t WS_WC1 = 202 * MiB;
constexpr size_t WS_H = 256 * MiB;
constexpr size_t WS_HB = 320 * MiB;
constexpr size_t WS_BG = 352 * MiB;
constexpr size_t WS_Z = 384 * MiB;
constexpr size_t WS_Y = 416 * MiB;
constexpr size_t WS_KV = 384 * MiB;
constexpr size_t WS_O = 448 * MiB;
constexpr size_t WS_SC = 480 * MiB;
constexpr size_t WS_SLAB = 544 * MiB;
constexpr size_t WS_UB = 640 * MiB;
constexpr size_t WS_VB = 768 * MiB;
constexpr size_t WS_USC = 896 * MiB;
constexpr size_t WS_VSC = 897 * MiB;
constexpr size_t WS_END = 898 * MiB;

constexpr int RING_BYTES = 155648;
constexpr int RS_OFF = RING_BYTES;
constexpr int MISC_OFF = RS_OFF + 4096;
constexpr int LDS_BYTES = 163840;
static_assert(MISC_OFF + 128 <= LDS_BYTES, "LDS map");

#define LDS_WAIT() asm volatile("s_waitcnt lgkmcnt(0)" ::: "memory")
#define VM_WAIT() asm volatile("s_waitcnt vmcnt(0)" ::: "memory")
#define RLX_AGENT __ATOMIC_RELAXED, __HIP_MEMORY_SCOPE_AGENT

__device__ __forceinline__ unsigned cvtpk(float lo, float hi) { f32x2 v = {lo, hi}; bf16x2_t b = __builtin_convertvector(v, bf16x2_t); return __builtin_bit_cast(unsigned, b); }
__device__ __forceinline__ float bf_lo(unsigned p) { return __uint_as_float(p << 16); }
__device__ __forceinline__ float bf_hi(unsigned p) { return __uint_as_float(p & 0xffff0000u); }
__device__ __forceinline__ float wave_sum(float v) {
#pragma unroll
    for (int o = 1; o < 64; o <<= 1) v += __shfl_xor(v, o);
    return v;
}
template <int CTRL> __device__ __forceinline__ float dpp_f(float x) { return __builtin_bit_cast(float, __builtin_amdgcn_update_dpp(0, __builtin_bit_cast(int, x), CTRL, 0xF, 0xF, true)); }
__device__ __forceinline__ float row_sum16(float x) { x += dpp_f<0xB1>(x); x += dpp_f<0x4E>(x); x += dpp_f<0x141>(x); x += dpp_f<0x140>(x); return x; }
__device__ __forceinline__ float rows_total(float x) {
    const float a = __builtin_bit_cast(float, __builtin_amdgcn_readlane(__builtin_bit_cast(int, x), 0)), b = __builtin_bit_cast(float, __builtin_amdgcn_readlane(__builtin_bit_cast(int, x), 16));
    const float c = __builtin_bit_cast(float, __builtin_amdgcn_readlane(__builtin_bit_cast(int, x), 32)), d = __builtin_bit_cast(float, __builtin_amdgcn_readlane(__builtin_bit_cast(int, x), 48));
    return (a + b) + (c + d);
}
__device__ __forceinline__ float gelu_tanh(float x) {
    const float y = 0.7978845608028654f * (x + 0.044715f * x * x * x);
    const float e = __builtin_amdgcn_exp2f(y * (2.0f * LOG2E));
    const float th = 1.0f - 2.0f * __builtin_amdgcn_rcpf(e + 1.0f);
    return 0.5f * x * (1.0f + th);
}
__device__ __forceinline__ float dot2(unsigned a, unsigned b, float acc) { return __builtin_amdgcn_fdot2_f32_bf16(__builtin_bit_cast(bf16x2_t, a), __builtin_bit_cast(bf16x2_t, b), acc, false); }

__device__ __forceinline__ int fresh_lane() { unsigned z = 0u; asm volatile("v_mov_b32 %0, 0" : "=v"(z)); return (int)__builtin_amdgcn_mbcnt_hi(~0u, __builtin_amdgcn_mbcnt_lo(~0u, z)); }
namespace pg8 {
constexpr int BM = 256, BK = 64, HALF = 128, HTB = HALF * BK * 2, STAGE_BYTES = 8 * HTB, NXCD = 8, WGM = 8;
__host__ __device__ __forceinline__ int lds_byte(int r, int c) { const int st = (r >> 4) * 2 + (c >> 5), rr = r & 15, cc = c & 31, ob = rr * 64 + cc * 2; return st * 1024 + (ob ^ (((ob >> 9) & 1) << 5)); }
__host__ __device__ __forceinline__ void stage_rc(int b, int& R, int& C) { const int st = b / 1024, sb = b % 1024, swz = sb ^ (((sb >> 9) & 1) << 5); R = (st >> 1) * 16 + swz / 64; C = (st & 1) * 32 + (swz % 64) / 2; }
__host__ __device__ __forceinline__ int perm32(int rho) { const int n = rho >> 4, i = rho & 15; return 8 * (i >> 2) + 4 * n + (i & 3); }

struct Unit { int pm, pn, ord; };
struct Gemm { int lda, ldb, K; };

struct PlainOrder {
    const char* A; const char* B; size_t tsA, tsB; int nM, nN, nwg, G, c;
    __device__ void init(const void* A_, int lda, const void* B_, int ldb, int M, int N, int G_, int c_) { A = (const char*)A_; B = (const char*)B_; tsA = (size_t)BM * lda * 2; tsB = (size_t)BM * ldb * 2; nM = M / BM; nN = N / BM; nwg = nM * nN; G = G_; c = c_; }
    __device__ bool next(int i, Unit& u) const {
        const long L = (long)i * G + c; if (L >= nwg) return false;
        int wgid = (int)L; { const int q = nwg / NXCD, r = nwg % NXCD, xcd = wgid % NXCD, off = wgid / NXCD; wgid = (xcd < r ? xcd * (q + 1) : r * (q + 1) + (xcd - r) * q) + off; }
        const int nig = WGM * nN, gid = wgid / nig, fm = gid * WGM, gsz = (nM - fm) < WGM ? (nM - fm) : WGM;
        u.pm = fm + ((wgid % nig) % gsz); u.pn = (wgid % nig) / gsz; u.ord = i; return true;
    }
    __device__ __forceinline__ const char* a_ptr(const Unit& u) const { return A + (size_t)u.pm * tsA; }
    __device__ __forceinline__ const char* b_ptr(const Unit& u) const { return B + (size_t)u.pn * tsB; }
};
struct FoldOrder {
    const char* A; const char* B; int G, c;
    __device__ bool next(int i, Unit& u) const { const int L = i * G + c; if (L >= 256) return false; u.pm = L >> 3; u.pn = L & 7; u.ord = i; return true; }
    __device__ __forceinline__ const char* a_ptr(const Unit& u) const { return A + (size_t)u.pm * 256 * 256 * 2; }
    __device__ __forceinline__ const char* b_ptr(const Unit& u) const { return B + (size_t)(u.pm >> 3) * 2048 * 2048 * 2 + (size_t)u.pn * 256 * 2048 * 2 + (size_t)(u.pm & 7) * 256 * 2; }
};
struct CmpOrder {
    const char* KV; const char* W; int G, c;
    __device__ bool next(int i, Unit& u) const { const int L = i * G + c; if (L >= 128) return false; u.pm = L; u.pn = 0; u.ord = i; return true; }
    __device__ __forceinline__ const char* a_ptr(const Unit& u) const { const int kv = u.pm >> 6, grp = (u.pm >> 3) & 7, ks = u.pm & 7; return KV + ((size_t)(kv * 8 + grp) * 4096 * 128 + (size_t)ks * 512) * 2; }
    __device__ __forceinline__ const char* b_ptr(const Unit& u) const { const int kv = u.pm >> 6, ks = u.pm & 7; return W + ((size_t)kv * 256 * 4096 + (size_t)ks * 512) * 2; }
};

typedef f32x4 Acc[2][2][4][2];

struct EpiConvIn {
    static constexpr bool PERM = true;
    bf16_t* Bg; bf16_t* Z; const LAS float* rs;
    __device__ __forceinline__ void operator()(const Acc& acc, const Unit& u, int wr, int wc, int fr, int fq) const {
#pragma unroll
        for (int ai = 0; ai < 2; ++ai)
#pragma unroll
            for (int m = 0; m < 4; ++m) {
                const int lr = ai * HALF + wr * 64 + m * 16 + fr; const float r = rs[u.ord * 256 + lr]; const size_t grow = (size_t)u.pm * BM + lr;
                if (u.pn < 8) {
#pragma unroll
                    for (int bj = 0; bj < 2; ++bj) { const f32x4 v0 = acc[ai][bj][m][0] * r, v1 = acc[ai][bj][m][1] * r;
                        u32x4 w; w.x = cvtpk(v0[0], v0[1]); w.y = cvtpk(v0[2], v0[3]); w.z = cvtpk(v1[0], v1[1]); w.w = cvtpk(v1[2], v1[3]);
                        *(u32x4*)(Bg + grow * DM + u.pn * 256 + bj * HALF + wc * 32 + 8 * fq) = w; }
                } else {
                    const float r2 = r * r;
                    const f32x4 v0 = acc[ai][0][m][0] * acc[ai][1][m][0] * r2, v1 = acc[ai][0][m][1] * acc[ai][1][m][1] * r2;
                    u32x4 w; w.x = cvtpk(v0[0], v0[1]); w.y = cvtpk(v0[2], v0[3]); w.z = cvtpk(v1[0], v1[1]); w.w = cvtpk(v1[2], v1[3]);
                    *(u32x4*)(Z + grow * DM + (u.pn - 8) * 128 + wc * 32 + 8 * fq) = w;
                }
            }
    }
};
struct EpiResid {
    static constexpr bool PERM = false;
    const float* base; float* H; bf16_t* Hb; float* ssq;
    __device__ __forceinline__ void operator()(const Acc& acc, const Unit& u, int wr, int wc, int fr, int fq) const {
#pragma unroll
        for (int ai = 0; ai < 2; ++ai)
#pragma unroll
            for (int m = 0; m < 4; ++m) {
                const int lr = ai * HALF + wr * 64 + m * 16 + fr; const size_t grow = (size_t)u.pm * BM + lr; const size_t off = grow * DM + u.pn * 256 + wc * 32 + 4 * fq;
                float s = 0.f;
#pragma unroll
                for (int bj = 0; bj < 2; ++bj)
#pragma unroll
                    for (int n = 0; n < 2; ++n) { const f32x4 b = *(const f32x4*)(base + off + bj * HALF + n * 16); const f32x4 o = b + acc[ai][bj][m][n];
                        *(f32x4*)(H + off + bj * HALF + n * 16) = o; s += (o[0] * o[0] + o[1] * o[1]) + (o[2] * o[2] + o[3] * o[3]);
                        u32x2 w; w.x = cvtpk(o[0], o[1]); w.y = cvtpk(o[2], o[3]); *(u32x2*)(Hb + off + bj * HALF + n * 16) = w; }
                s += __shfl_xor(s, 16); s += __shfl_xor(s, 32);
                if (fq == 0) ssq[grow * 32 + u.pn * 4 + wc] = s;
            }
    }
};
struct EpiNsaIn {
    static constexpr bool PERM = true;
    bf16_t* Q; bf16_t* KV; float* gates; const LAS float* rs;
    __device__ __forceinline__ void operator()(const Acc& acc, const Unit& u, int wr, int wc, int fr, int fq) const {
#pragma unroll
        for (int ai = 0; ai < 2; ++ai)
#pragma unroll
            for (int m = 0; m < 4; ++m) {
                const int lr = ai * HALF + wr * 64 + m * 16 + fr; const float r = rs[u.ord * 256 + lr]; const size_t grow = (size_t)u.pm * BM + lr;
                if (u.pn < 8) {
                    const float rq = r * QSCALE;
#pragma unroll
                    for (int bj = 0; bj < 2; ++bj) { const f32x4 v0 = acc[ai][bj][m][0] * rq, v1 = acc[ai][bj][m][1] * rq;
                        u32x4 w; w.x = cvtpk(v0[0], v0[1]); w.y = cvtpk(v0[2], v0[3]); w.z = cvtpk(v1[0], v1[1]); w.w = cvtpk(v1[2], v1[3]);
                        *(u32x4*)(Q + grow * DM + u.pn * 256 + bj * HALF + wc * 32 + 8 * fq) = w; }
                } else if (u.pn < 20) {
                    const int nn = (u.pn - 8) >> 1, b = (int)(grow >> 12), s = (int)(grow & 4095);
#pragma unroll
                    for (int bj = 0; bj < 2; ++bj) { const int g = ((u.pn - 8) & 1) * 2 + bj; const f32x4 v0 = acc[ai][bj][m][0] * r, v1 = acc[ai][bj][m][1] * r;
                        u32x4 w; w.x = cvtpk(v0[0], v0[1]); w.y = cvtpk(v0[2], v0[3]); w.z = cvtpk(v1[0], v1[1]); w.w = cvtpk(v1[2], v1[3]);
                        *(u32x4*)(KV + ((size_t)((nn * 2 + b) * 4 + g) * 4096 + s) * 128 + wc * 32 + 8 * fq) = w; }
                } else {
                    const int col = wc * 32 + 8 * fq;
                    if (col < 48) {
                        f32x4 v0 = acc[ai][0][m][0] * r, v1 = acc[ai][0][m][1] * r;
#pragma unroll
                        for (int j = 0; j < 4; ++j) { v0[j] = __builtin_amdgcn_rcpf(1.0f + __builtin_amdgcn_exp2f(-v0[j] * LOG2E)); v1[j] = __builtin_amdgcn_rcpf(1.0f + __builtin_amdgcn_exp2f(-v1[j] * LOG2E)); }
                        *(f32x4*)(gates + grow * 48 + col) = v0; *(f32x4*)(gates + grow * 48 + col + 4) = v1;
                    }
                }
            }
    }
};
struct EpiScores {
    static constexpr bool PERM = true;
    bf16_t* S; const LAS float* rs;
    __device__ __forceinline__ void operator()(const Acc& acc, const Unit& u, int wr, int wc, int fr, int fq) const {
#pragma unroll
        for (int ai = 0; ai < 2; ++ai)
#pragma unroll
            for (int m = 0; m < 4; ++m) {
                const int lr = ai * HALF + wr * 64 + m * 16 + fr; const float r = rs[u.ord * 256 + lr]; bf16_t* rowp = S + ((size_t)u.pm * BM + lr) * DM + u.pn * 256 + wc * 32 + 8 * fq;
#pragma unroll
                for (int bj = 0; bj < 2; ++bj) { const f32x4 v0 = acc[ai][bj][m][0] * r, v1 = acc[ai][bj][m][1] * r;
                    u32x4 w; w.x = cvtpk(v0[0], v0[1]); w.y = cvtpk(v0[2], v0[3]); w.z = cvtpk(v1[0], v1[1]); w.w = cvtpk(v1[2], v1[3]);
                    *(u32x4*)(rowp + bj * HALF) = w; }
            }
    }
};
struct EpiSlab {
    static constexpr bool PERM = true;
    bf16_t* slab;
    __device__ __forceinline__ void operator()(const Acc& acc, const Unit& u, int wr, int wc, int fr, int fq) const {
        const int kv = u.pm >> 6, grp = (u.pm >> 3) & 7, ks = u.pm & 7;
        bf16_t* base = slab + ((size_t)(ks * 2 + kv) * 2048 + grp * 256) * 256;
#pragma unroll
        for (int ai = 0; ai < 2; ++ai)
#pragma unroll
            for (int m = 0; m < 4; ++m) {
                const int lr = ai * HALF + wr * 64 + m * 16 + fr; bf16_t* rowp = base + (size_t)lr * 256 + wc * 32 + 8 * fq;
#pragma unroll
                for (int bj = 0; bj < 2; ++bj) { const f32x4 v0 = acc[ai][bj][m][0], v1 = acc[ai][bj][m][1];
                    u32x4 w; w.x = cvtpk(v0[0], v0[1]); w.y = cvtpk(v0[2], v0[3]); w.z = cvtpk(v1[0], v1[1]); w.w = cvtpk(v1[2], v1[3]);
                    *(u32x4*)(rowp + bj * HALF) = w; }
            }
    }
};
struct EpiBf16 {
    static constexpr bool PERM = true;
    bf16_t* O; int ldc;
    __device__ __forceinline__ void operator()(const Acc& acc, const Unit& u, int wr, int wc, int fr, int fq) const {
#pragma unroll
        for (int ai = 0; ai < 2; ++ai)
#pragma unroll
            for (int m = 0; m < 4; ++m) {
                const int lr = ai * HALF + wr * 64 + m * 16 + fr; bf16_t* rowp = O + ((size_t)u.pm * BM + lr) * ldc + u.pn * 256 + wc * 32 + 8 * fq;
#pragma unroll
                for (int bj = 0; bj < 2; ++bj) { const f32x4 v0 = acc[ai][bj][m][0], v1 = acc[ai][bj][m][1];
                    u32x4 w; w.x = cvtpk(v0[0], v0[1]); w.y = cvtpk(v0[2], v0[3]); w.z = cvtpk(v1[0], v1[1]); w.w = cvtpk(v1[2], v1[3]);
                    *(u32x4*)(rowp + bj * HALF) = w; }
            }
    }
};

template <int LDA, int LDB, int KLEN, class Epi, class Sched>
__device__ __forceinline__ void gemm_phase(LAS unsigned char* lds, int tid, const Sched& S, const Epi& E) {
    constexpr Gemm g{LDA, LDB, KLEN};
    const int wid = __builtin_amdgcn_readfirstlane(tid >> 6), lane = tid & 63, wr = wid >> 2, wc = wid & 3, fr = lane & 15, fq = lane >> 4;
    const int nt = g.K / BK;
    unsigned voffA[2], voffB[2];
#pragma unroll
    for (int i = 0; i < 2; ++i) { int R, C; stage_rc(tid * 16 + i * 8192, R, C); const int Rb = Epi::PERM ? ((R & ~31) + perm32(R & 31)) : R;
        voffA[i] = (unsigned)(R * g.lda + C) * 2u; voffB[i] = (unsigned)(Rb * g.ldb + C) * 2u; }
    const size_t kstep = (size_t)(BK * 2);
    const size_t hstepA = (size_t)HALF * g.lda * 2, hstepB = (size_t)HALF * g.ldb * 2;
    const unsigned ldsw = (unsigned)wid * 1024u;
    const int aoff = lds_byte(wr * 64 + fr, fq * 8), boff = lds_byte(wc * 32 + fr, fq * 8);
#define PG8_SA(b, h) (((b) * 2 + (h)) * HTB)
#define PG8_SB(b, h) ((4 + (b) * 2 + (h)) * HTB)
#define PG8_STAGE(bufoff, gbase, voff) do { _Pragma("unroll") for (int _i = 0; _i < 2; ++_i) \
        __builtin_amdgcn_global_load_lds((const unsigned*)((const char*)(gbase) + (voff)[_i]), (LAS unsigned*)(lds + (bufoff) + ldsw + _i * 8192), 16, 0, 0); } while (0)
#define PG8_LDA(dst, b, h) do { _Pragma("unroll") for (int m = 0; m < 4; ++m) _Pragma("unroll") for (int k = 0; k < 2; ++k) dst[m][k] = *(const LAS bf16x8*)(lds + PG8_SA(b, h) + aoff + m * 2048 + k * 1024); } while (0)
#define PG8_LDB(dst, b, h) do { _Pragma("unroll") for (int n = 0; n < 2; ++n) _Pragma("unroll") for (int k = 0; k < 2; ++k) dst[n][k] = *(const LAS bf16x8*)(lds + PG8_SB(b, h) + boff + n * 2048 + k * 1024); } while (0)
#define PG8_MMA(ai, bj, At, Bt) do { __builtin_amdgcn_s_setprio(1); _Pragma("unroll") for (int m = 0; m < 4; ++m) _Pragma("unroll") for (int n = 0; n < 2; ++n) _Pragma("unroll") for (int k = 0; k < 2; ++k) \
        acc[ai][bj][m][n] = __builtin_amdgcn_mfma_f32_16x16x32_bf16(Bt[n][k], At[m][k], acc[ai][bj][m][n], 0, 0, 0); __builtin_amdgcn_s_setprio(0); } while (0)
#define PG8_WAIT_V(n) asm volatile("s_waitcnt vmcnt(" #n ")" ::: "memory")
#define PG8_WAIT_L(n) asm volatile("s_waitcnt lgkmcnt(" #n ")" ::: "memory")
#define PG8_BAR __builtin_amdgcn_s_barrier()
#define PG8_SCHED __builtin_amdgcn_sched_barrier(0)
    Unit cur, nxt; int ui = 0;
    if (!S.next(0, cur)) return;
    Acc acc;
#pragma unroll
    for (int a = 0; a < 2; ++a)
#pragma unroll
        for (int b = 0; b < 2; ++b)
#pragma unroll
            for (int m = 0; m < 4; ++m)
#pragma unroll
                for (int n = 0; n < 2; ++n) acc[a][b][m][n] = (f32x4){0.f, 0.f, 0.f, 0.f};
    bf16x8 At[4][2], B0[2][2], B1[2][2];
    const char* cA = S.a_ptr(cur); const char* cB = S.b_ptr(cur);
    asm volatile("" : "+s"(cA), "+s"(cB));
    PG8_STAGE(PG8_SB(0, 0), cB, voffB); PG8_STAGE(PG8_SB(0, 1), cB + hstepB, voffB); PG8_STAGE(PG8_SA(0, 0), cA, voffA); PG8_STAGE(PG8_SA(0, 1), cA + hstepA, voffA);
    if (wr == 1) PG8_BAR;
    PG8_WAIT_V(2); PG8_BAR;
    PG8_STAGE(PG8_SB(1, 0), cB + kstep, voffB); PG8_STAGE(PG8_SA(1, 0), cA + kstep, voffA); PG8_STAGE(PG8_SB(1, 1), cB + hstepB + kstep, voffB);
    PG8_WAIT_V(6); PG8_BAR;
    for (;;) {
        const bool has_next = S.next(ui + 1, nxt);
        const char* nA = has_next ? S.a_ptr(nxt) : cA; const char* nB = has_next ? S.b_ptr(nxt) : cB;
        asm volatile("" : "+s"(nA), "+s"(nB));
        for (int t = 0; t < nt; t += 2) {
            const bool last = (t == nt - 2);
            const char* a1 = cA + (size_t)(t + 1) * kstep;
            const char* a2 = last ? nA : cA + (size_t)(t + 2) * kstep; const char* b2 = last ? nB : cB + (size_t)(t + 2) * kstep;
            const char* a3 = a2 + kstep; const char* b3 = b2 + kstep;
            asm volatile("" : "+s"(a1), "+s"(a2), "+s"(b2), "+s"(a3), "+s"(b3));
            PG8_LDB(B0, 0, 0); PG8_LDB(B1, 0, 1); PG8_SCHED; PG8_LDA(At, 0, 0); PG8_STAGE(PG8_SA(1, 1), a1 + hstepA, voffA);
            PG8_WAIT_V(8); PG8_WAIT_L(0); PG8_BAR; PG8_MMA(0, 0, At, B0); PG8_MMA(0, 1, At, B1); PG8_BAR; PG8_SCHED;
            PG8_LDA(At, 0, 1); PG8_STAGE(PG8_SB(0, 0), b2, voffB); PG8_STAGE(PG8_SB(0, 1), b2 + hstepB, voffB); PG8_STAGE(PG8_SA(0, 0), a2, voffA);
            PG8_WAIT_V(8); PG8_WAIT_L(0); PG8_BAR; PG8_MMA(1, 0, At, B0); PG8_MMA(1, 1, At, B1); PG8_BAR; PG8_SCHED;
            PG8_LDB(B0, 1, 0); PG8_LDB(B1, 1, 1); PG8_SCHED; PG8_LDA(At, 1, 0); PG8_STAGE(PG8_SA(0, 1), a2 + hstepA, voffA);
            PG8_WAIT_V(8); PG8_WAIT_L(0); PG8_BAR; PG8_MMA(0, 0, At, B0); PG8_MMA(0, 1, At, B1); PG8_BAR; PG8_SCHED;
            PG8_LDA(At, 1, 1); PG8_STAGE(PG8_SB(1, 0), b3, voffB); PG8_STAGE(PG8_SB(1, 1), b3 + hstepB, voffB); PG8_STAGE(PG8_SA(1, 0), a3, voffA);
            PG8_WAIT_V(8); PG8_WAIT_L(0); PG8_BAR; PG8_MMA(1, 0, At, B0); PG8_MMA(1, 1, At, B1); PG8_BAR; PG8_SCHED;
        }
        if (wr == 0) PG8_BAR;
        { const int l_e = fresh_lane();
          E(acc, cur, wr, wc, l_e & 15, l_e >> 4); }
        if (!has_next) break;
#pragma unroll
        for (int a = 0; a < 2; ++a)
#pragma unroll
            for (int b = 0; b < 2; ++b)
#pragma unroll
                for (int m = 0; m < 4; ++m)
#pragma unroll
                    for (int n = 0; n < 2; ++n) acc[a][b][m][n] = (f32x4){0.f, 0.f, 0.f, 0.f};
        cur = nxt; cA = nA; cB = nB; ++ui;
        if (wr == 1) PG8_BAR;
    }
    PG8_WAIT_V(0);
    PG8_BAR;
#undef PG8_SA
#undef PG8_SB
#undef PG8_STAGE
#undef PG8_LDA
#undef PG8_LDB
#undef PG8_MMA
#undef PG8_WAIT_V
#undef PG8_WAIT_L
#undef PG8_BAR
#undef PG8_SCHED
}
}

#define XB_TMO      128
#define XB_XCNT(j)  (256  + 64 * (j))
#define XB_XSUB(j)  (1280 + 64 * (j))
#define XB_XGEN(j)  (2304 + 64 * (j))
#define XB_TOP      3328
#define XB_TOPGEN   3392
#define XCD_BAR_WORDS 3456
#define XB_SPIN_CAP (1u << 22)
__device__ __forceinline__ unsigned xb_ld(unsigned* p)              { return __hip_atomic_load(p, __ATOMIC_RELAXED, __HIP_MEMORY_SCOPE_AGENT); }
__device__ __forceinline__ unsigned xb_add(unsigned* p, unsigned v) { return __hip_atomic_fetch_add(p, v, __ATOMIC_RELAXED, __HIP_MEMORY_SCOPE_AGENT); }
__device__ __forceinline__ unsigned xb_xcc_id() { return (unsigned)__builtin_amdgcn_s_getreg((3 << 11) | 20) & 0xFu; }
#define XB_SPIN(cond, bar) do { unsigned _sp = 0; while (cond) { __builtin_amdgcn_s_sleep(1); \
    if ((++_sp & 255u) == 0u) { if (xb_ld(&(bar)[XB_TMO])) break; if (_sp > XB_SPIN_CAP) { atomicAdd(&(bar)[XB_TMO], 1u); break; } } } } while (0)
struct XcdBarrier { unsigned* bar; unsigned x; volatile LAS unsigned* st; };
__device__ __forceinline__ XcdBarrier xcd_barrier_post(unsigned* bar, volatile LAS unsigned* st) {
    XcdBarrier b; b.bar = bar; b.x = xb_xcc_id(); b.st = st;
    if (threadIdx.x == 0) (void)xb_add(&bar[XB_XCNT(b.x)], 1u);
    return b;
}
__device__ __forceinline__ void xcd_barrier_complete(unsigned* bar, unsigned x, unsigned& nloc, unsigned& nx) {
    const unsigned G = gridDim.x * gridDim.y * gridDim.z;
    unsigned sum, cnt, mine, sp = 0u;
    for (;;) {
        sum = 0u; cnt = 0u; mine = 0u;
#pragma unroll
        for (unsigned j = 0; j < 16; ++j) { const unsigned c = xb_ld(&bar[XB_XCNT(j)]); sum += c; cnt += (c > 0u) ? 1u : 0u; }
        mine = xb_ld(&bar[XB_XCNT(x)]);
        if (sum == G) break;
        __builtin_amdgcn_s_sleep(1);
        if ((++sp & 255u) == 0u) { if (xb_ld(&bar[XB_TMO])) break; if (sp > XB_SPIN_CAP) { atomicAdd(&bar[XB_TMO], 1u); break; } }
    }
    nloc = mine > 0u ? mine : 1u; nx = cnt > 0u ? cnt : 1u;
}
__device__ __forceinline__ void xcd_barrier(const XcdBarrier& b, int wave) {
    asm volatile("s_waitcnt vmcnt(0)" ::: "memory");
    __syncthreads();
    if (wave == 0 && fresh_lane() == 0) {
        unsigned* bar = b.bar; asm volatile("" : "+s"(bar));
        __builtin_amdgcn_s_waitcnt(0);
        unsigned nloc = b.st[0], nx = b.st[1];
        if (nloc == 0u) { xcd_barrier_complete(bar, b.x, nloc, nx); b.st[0] = nloc; b.st[1] = nx; }
        const unsigned old = xb_add(&bar[XB_XSUB(b.x)], 1u);
        const unsigned gen = old / nloc;
        if (old + 1u == (gen + 1u) * nloc) {
            __builtin_amdgcn_fence(__ATOMIC_RELEASE, "agent");
            asm volatile("s_waitcnt vmcnt(0)" ::: "memory");
            const unsigned og = xb_add(&bar[XB_TOP], 1u);
            const unsigned tg = og / nx;
            if (og + 1u == (tg + 1u) * nx) xb_add(&bar[XB_TOPGEN], 1u);
            else XB_SPIN(xb_ld(&bar[XB_TOPGEN]) == tg, bar);
            __builtin_amdgcn_fence(__ATOMIC_ACQUIRE, "agent");
            xb_add(&bar[XB_XGEN(b.x)], 1u);
            asm volatile("s_waitcnt vmcnt(0)" ::: "memory");
        } else {
            XB_SPIN(xb_ld(&bar[XB_XGEN(b.x)]) == gen, bar);
            __builtin_amdgcn_fence(__ATOMIC_ACQUIRE, "agent");
            asm volatile("s_waitcnt vmcnt(0)" ::: "memory");
        }
    }
    __syncthreads();
}

struct Args {
    const float* x; const float* rel_bias; const float* mix_norm; const float* ffn_norm; const float* final_norm;
    const float* conv_w_in; const float* conv_kernel; const float* conv_w_out;
    const float* nsa_w_in; const float* cmp_pos_k; const float* cmp_pos_v; const float* cmp_w1_k; const float* cmp_w2_k; const float* cmp_w1_v; const float* cmp_w2_v; const float* nsa_w_out;
    const float* peer_w_q; const float* peer_sub_keys; const float* peer_u; const float* peer_v;
    float* out; unsigned char* ws; int ph_lo, ph_hi, li, pad;
};
struct Frame { LAS unsigned char* lds; int tid, lane, wave, vcu, G; };

struct TrItem { const float* W; const float* gain; bf16_t* WT; int K, Nsrc, k0, n0, sn0; };
__device__ __forceinline__ void tr_load(const TrItem& t, f32x4 (&tv)[8], int lane) {
#pragma unroll
    for (int i = 0; i < 8; ++i) { const int kk = 8 * i + (lane >> 3), col = 4 * (lane & 7); const float* p = t.W + (size_t)(t.k0 + kk) * t.Nsrc + t.sn0 + col;
        if (t.sn0 + col + 3 < t.Nsrc) tv[i] = *(const f32x4*)p;
        else { tv[i][0] = t.sn0 + col < t.Nsrc ? p[0] : 0.f; tv[i][1] = t.sn0 + col + 1 < t.Nsrc ? p[1] : 0.f; tv[i][2] = t.sn0 + col + 2 < t.Nsrc ? p[2] : 0.f; tv[i][3] = 0.f; } }
}
__device__ __forceinline__ void tr_finish(const TrItem& t, const f32x4 (&tv)[8], LAS float* scr, int lane) {
#pragma unroll
    for (int i = 0; i < 8; ++i) { const int kk = 8 * i + (lane >> 3), col = 4 * (lane & 7); const float gk = t.gain ? t.gain[t.k0 + kk] : 1.0f;
        scr[kk * 33 + col] = tv[i][0] * gk; scr[kk * 33 + col + 1] = tv[i][1] * gk; scr[kk * 33 + col + 2] = tv[i][2] * gk; scr[kk * 33 + col + 3] = tv[i][3] * gk; }
    LDS_WAIT(); asm volatile("" ::: "memory");
    const int c = lane & 7;
#pragma unroll
    for (int j = 0; j < 4; ++j) { const int n = (lane >> 3) + 8 * j; const LAS float* s = scr + (8 * c) * 33 + n;
        u32x4 o; o.x = cvtpk(s[0 * 33], s[1 * 33]); o.y = cvtpk(s[2 * 33], s[3 * 33]); o.z = cvtpk(s[4 * 33], s[5 * 33]); o.w = cvtpk(s[6 * 33], s[7 * 33]);
        *(u32x4*)(t.WT + (size_t)(t.n0 + n) * t.K + t.k0 + 8 * c) = o; }
    LDS_WAIT(); asm volatile("" ::: "memory");
}
__device__ __forceinline__ void tr_set(TrItem& t, const float* W, int K, int Nsrc, int Ndst, const float* gain, bf16_t* WT, int item, int mode) {
    const int nblk = Ndst / 32, kb = item / nblk, nb = item % nblk; t.W = W; t.gain = gain; t.WT = WT; t.K = K; t.Nsrc = Nsrc; t.k0 = 64 * kb; t.n0 = 32 * nb; t.sn0 = t.n0;
    if (mode == 1 && t.n0 >= 2048) { const int r = t.n0 - 2048, kk = r >> 8, xx = r & 255; t.sn0 = xx < 128 ? 2048 + 128 * kk + xx : 4096 + 128 * kk + (xx - 128); }
}

__device__ __forceinline__ void convert_expert_rows(const Args& a, unsigned char* ws, int lane, int row_lo, int row_hi, int rw, int nw, int reps) {
    for (int tb = 0; tb < 2 * reps; ++tb) {
        const float* src = (tb & 1) ? a.peer_v : a.peer_u; unsigned char* dst = ws + ((tb & 1) ? WS_VB : WS_UB); float* scl = (float*)(ws + ((tb & 1) ? WS_VSC : WS_USC));
#define EXP_LOAD(v_, row_) do { const float* sr = src + (size_t)(row_) * DM + 4 * lane; _Pragma("unroll") for (int j = 0; j < 2; ++j) _Pragma("unroll") for (int i = 0; i < 4; ++i) v_[j][i] = __builtin_nontemporal_load((const f32x4*)(sr + 256 * (i + 4 * j))); } while (0)
#define EXP_DONE(v_, row_) do { float ss = 0.f; \
            _Pragma("unroll") for (int j = 0; j < 2; ++j) _Pragma("unroll") for (int i = 0; i < 4; ++i) ss += (v_[j][i][0] * v_[j][i][0] + v_[j][i][1] * v_[j][i][1]) + (v_[j][i][2] * v_[j][i][2] + v_[j][i][3] * v_[j][i][3]); \
            ss = rows_total(row_sum16(ss)); \
            const float rms = __builtin_sqrtf(ss * (1.0f / DM)); u32x4 o; \
            if (tb & 1) { const float sc = rms > 0.f ? 2.0f / rms : 1.0f; \
                _Pragma("unroll") for (int i = 0; i < 4; ++i) { unsigned w_ = 0u; \
                    w_ = __builtin_amdgcn_cvt_scalef32_pk_fp4_f32(w_, v_[0][i][0] * sc, v_[1][i][0] * sc, 1.0f, 0); w_ = __builtin_amdgcn_cvt_scalef32_pk_fp4_f32(w_, v_[0][i][1] * sc, v_[1][i][1] * sc, 1.0f, 1); \
                    w_ = __builtin_amdgcn_cvt_scalef32_pk_fp4_f32(w_, v_[0][i][2] * sc, v_[1][i][2] * sc, 1.0f, 2); w_ = __builtin_amdgcn_cvt_scalef32_pk_fp4_f32(w_, v_[0][i][3] * sc, v_[1][i][3] * sc, 1.0f, 3); o[i] = w_; } \
                if (lane == 0) scl[row_] = rms > 0.f ? rms * 0.5f : 1.0f; \
            } else { const float step = 0.3352f * rms, sc = rms > 0.f ? 1.0f / step : 0.f; \
                _Pragma("unroll") for (int i = 0; i < 4; ++i) { unsigned w_ = 0u; \
                    _Pragma("unroll") for (int c = 0; c < 4; ++c) { const int q0 = (int)__builtin_fminf(__builtin_fmaxf(__builtin_floorf(v_[0][i][c] * sc), -8.0f), 7.0f), q1 = (int)__builtin_fminf(__builtin_fmaxf(__builtin_floorf(v_[1][i][c] * sc), -8.0f), 7.0f); \
                        w_ |= (((unsigned)q0 & 15u) | (((unsigned)q1 & 15u) << 4)) << (8 * c); } \
                    o[i] = w_; } \
                if (lane == 0) scl[row_] = step; } \
            *(u32x4*)(dst + (size_t)(row_) * EROW + 16 * lane) = o; } while (0)
        {
            f32x4 va[2][4], vb[2][4];
            int row = row_lo + rw;
            if (row < row_hi) EXP_LOAD(va, row);
            for (; row < row_hi; row += 2 * nw) {
                const int r1 = row + nw, r2 = row + 2 * nw;
                if (r1 < row_hi) EXP_LOAD(vb, r1);
                __builtin_amdgcn_sched_barrier(0);
                EXP_DONE(va, row);
                if (r2 < row_hi) EXP_LOAD(va, r2);
                __builtin_amdgcn_sched_barrier(0);
                if (r1 < row_hi) EXP_DONE(vb, r1);
            }
        }
#undef EXP_LOAD
#undef EXP_DONE
    }
}

__device__ __forceinline__ void p0_prologue(const Frame& F, const Args& a) {
    unsigned char* ws = a.ws;
    LAS float* scr = (LAS float*)(F.lds + F.wave * 16384);
    const int gw = F.vcu * 8 + F.wave, NGW = F.G * 8;
    for (int it = gw; it < 256; it += NGW) {
        const int chunk = it & 63, kv = (it >> 6) & 1, j = it >> 7;
        const float* pos = (kv ? a.cmp_pos_v : a.cmp_pos_k) + (size_t)j * 4096; const float* w1 = (kv ? a.cmp_w1_v : a.cmp_w1_k) + (size_t)j * 4096 * 256;
        f32x4 acc[8];
#pragma unroll
        for (int u = 0; u < 8; ++u) acc[u] = (f32x4){0.f, 0.f, 0.f, 0.f};
        for (int k = chunk * 64; k < chunk * 64 + 64; k += 8) {
#pragma unroll
            for (int u = 0; u < 8; ++u) acc[u] += *(const f32x4*)(w1 + (size_t)(k + u) * 256 + 4 * F.lane) * pos[k + u]; }
        *(f32x4*)((float*)(ws + WS_BIAS1P) + (size_t)it * 256 + 4 * F.lane) = ((acc[0] + acc[1]) + (acc[2] + acc[3])) + ((acc[4] + acc[5]) + (acc[6] + acc[7]));
    }
    constexpr int I_CIN = 32 * (NCIN / 32), I_SQ = 32 * (DM / 32), I_NIN = 32 * (NNPAD / 32), I_C1 = 64 * (256 / 32);
    constexpr int NIT = 2 * I_CIN + 2 * I_SQ + 2 * I_NIN + 2 * I_SQ + 4 * I_C1;
#define TR_DECODE(t_, it_) do { int r = (it_); \
        if (r < 2 * I_CIN) { const int j = r / I_CIN; r -= j * I_CIN; tr_set(t_, a.conv_w_in + (size_t)j * DM * NCIN, DM, NCIN, NCIN, a.mix_norm + (size_t)(2 * j) * DM, (bf16_t*)(ws + WS_WCIN) + (size_t)j * NCIN * DM, r, 1); break; } r -= 2 * I_CIN; \
        if (r < 2 * I_SQ) { const int j = r / I_SQ; r -= j * I_SQ; tr_set(t_, a.conv_w_out + (size_t)j * DM * DM, DM, DM, DM, nullptr, (bf16_t*)(ws + WS_WCOUT) + (size_t)j * DM * DM, r, 0); break; } r -= 2 * I_SQ; \
        if (r < 2 * I_NIN) { const int j = r / I_NIN; r -= j * I_NIN; tr_set(t_, a.nsa_w_in + (size_t)j * DM * NNIN, DM, NNIN, NNPAD, a.mix_norm + (size_t)(2 * j + 1) * DM, (bf16_t*)(ws + WS_WNIN) + (size_t)j * NNPAD * DM, r, 2); break; } r -= 2 * I_NIN; \
        if (r < 2 * I_SQ) { const int j = r / I_SQ; r -= j * I_SQ; tr_set(t_, a.nsa_w_out + (size_t)j * DM * DM, DM, DM, DM, nullptr, (bf16_t*)(ws + WS_WNOUT) + (size_t)j * DM * DM, r, 0); break; } r -= 2 * I_SQ; \
        { const int q = r / I_C1; r -= q * I_C1; const int j = q >> 1, kv = q & 1; tr_set(t_, (kv ? a.cmp_w1_v : a.cmp_w1_k) + (size_t)j * 4096 * 256, 4096, 256, 256, nullptr, (bf16_t*)(ws + WS_WC1) + (size_t)q * 256 * 4096, r, 0); } } while (0)
    for (int rep = 0; rep < (((PROBE_MASK >> 13) & 1) ? 2 : 1); ++rep) {
        TrItem ta, tb; f32x4 va[8], vb[8];
        int it = gw;
        if (it < NIT) { TR_DECODE(ta, it); tr_load(ta, va, F.lane); }
        for (; it < NIT; it += 2 * NGW) {
            const int i1 = it + NGW, i2 = it + 2 * NGW;
            if (i1 < NIT) { TR_DECODE(tb, i1); tr_load(tb, vb, F.lane); }
            __builtin_amdgcn_sched_barrier(0);
            tr_finish(ta, va, scr, F.lane);
            if (i2 < NIT) { TR_DECODE(ta, i2); tr_load(ta, va, F.lane); }
            __builtin_amdgcn_sched_barrier(0);
            if (i1 < NIT) tr_finish(tb, vb, scr, F.lane);
        }
    }
#undef TR_DECODE
    const size_t gt = (size_t)F.vcu * 512 + F.tid, NGT = (size_t)F.G * 512;
    for (size_t ch = gt; ch < (size_t)DEPTH * DM * DM / 8; ch += 2 * NGT) {
        f32x4 v[2][2]; float gk[2];
#pragma unroll
        for (int q = 0; q < 2; ++q) { const size_t e = (ch + q * NGT) * 8; const int i = (int)(e / ((size_t)DM * DM)), k = (int)((e / DM) % DM); gk[q] = a.ffn_norm[i * DM + k];
            v[q][0] = *(const f32x4*)(a.peer_w_q + e); v[q][1] = *(const f32x4*)(a.peer_w_q + e + 4); }
#pragma unroll
        for (int q = 0; q < 2; ++q) { const size_t e = (ch + q * NGT) * 8; const f32x4 v0 = v[q][0] * gk[q], v1 = v[q][1] * gk[q];
            u32x4 o; o.x = cvtpk(v0[0], v0[1]); o.y = cvtpk(v0[2], v0[3]); o.z = cvtpk(v1[0], v1[1]); o.w = cvtpk(v1[2], v1[3]);
            *(u32x4*)((bf16_t*)(ws + WS_WQN) + e) = o; }
    }
    for (size_t ch = gt; ch < (size_t)DEPTH * 2048 * 256 / 8; ch += NGT) {
        const size_t e = ch * 8; const int col = (int)(e & 255), row = (int)((e >> 8) & 2047), i = (int)(e >> 19);
        const int p = (row >> 7) & 1; u32x4 o = (u32x4){0u, 0u, 0u, 0u};
        if ((col >> 7) == p) { const float* src = a.peer_sub_keys + ((size_t)i * 2048 + row) * 128 + (col & 127);
            const f32x4 v0 = *(const f32x4*)src, v1 = *(const f32x4*)(src + 4);
            o.x = cvtpk(v0[0], v0[1]); o.y = cvtpk(v0[2], v0[3]); o.z = cvtpk(v1[0], v1[1]); o.w = cvtpk(v1[2], v1[3]); }
        *(u32x4*)((bf16_t*)(ws + WS_KEYSPAD) + e) = o;
    }
    convert_expert_rows(a, ws, F.lane, 0, 2 * NEXP, gw, NGW, ((PROBE_MASK >> 12) & 1) ? 2 : 1);
    for (int m = gw; m < T; m += NGW) {
        const float* xr = a.x + (size_t)m * DM; bf16_t* hb = (bf16_t*)(ws + WS_HB) + (size_t)m * DM; float s = 0.f;
#pragma unroll
        for (int j = 0; j < 4; ++j) { const int e0 = 512 * j + 8 * F.lane; const f32x4 v0 = *(const f32x4*)(xr + e0), v1 = *(const f32x4*)(xr + e0 + 4);
            s += (v0[0] * v0[0] + v0[1] * v0[1]) + (v0[2] * v0[2] + v0[3] * v0[3]) + (v1[0] * v1[0] + v1[1] * v1[1]) + (v1[2] * v1[2] + v1[3] * v1[3]);
            u32x4 o; o.x = cvtpk(v0[0], v0[1]); o.y = cvtpk(v0[2], v0[3]); o.z = cvtpk(v1[0], v1[1]); o.w = cvtpk(v1[2], v1[3]); *(u32x4*)(hb + e0) = o; }
        s = wave_sum(s);
        if (F.lane < 32) ((float*)(ws + WS_SSQ))[(size_t)m * 32 + F.lane] = F.lane == 0 ? s : 0.f;
    }
}

template <class Sched>
__device__ __forceinline__ void fill_rstd(const Frame& F, const Sched& S, const float* ssq) {
    LAS float* rs = (LAS float*)(F.lds + RS_OFF);
    pg8::Unit u;
    for (int i = 0; S.next(i, u); ++i) {
        if (F.tid < 256) { const f32x4* p = (const f32x4*)(ssq + ((size_t)u.pm * 256 + F.tid) * 32); float s = 0.f;
#pragma unroll
            for (int k = 0; k < 8; ++k) { const f32x4 v = p[k]; s += (v[0] + v[1]) + (v[2] + v[3]); }
            rs[i * 256 + F.tid] = rsqrtf(s * (1.0f / DM) + EPS); }
    }
    __syncthreads();
}

__device__ __forceinline__ void conv_gate_phase(const Frame& F, const bf16_t* Bg, const bf16_t* Z, const float* ck, bf16_t* Y) {
    const int gt = F.vcu * 512 + F.tid, NGT = F.G * 512;
    for (int it = gt; it < (T / 16) * 256; it += NGT) {
        const int c8 = (it & 255) * 8, r0 = (it >> 8) * 16, s0 = r0 & (SEQ - 1);
        float k0[8], k1[8], k2[8];
        *(f32x4*)k0 = *(const f32x4*)(ck + c8); *(f32x4*)(k0 + 4) = *(const f32x4*)(ck + c8 + 4);
        *(f32x4*)k1 = *(const f32x4*)(ck + DM + c8); *(f32x4*)(k1 + 4) = *(const f32x4*)(ck + DM + c8 + 4);
        *(f32x4*)k2 = *(const f32x4*)(ck + 2 * DM + c8); *(f32x4*)(k2 + 4) = *(const f32x4*)(ck + 2 * DM + c8 + 4);
        u32x4 z1 = (u32x4){0u, 0u, 0u, 0u}, z2 = z1;
        if (s0 >= 1) z1 = *(const u32x4*)(Z + (size_t)(r0 - 1) * DM + c8);
        if (s0 >= 2) z2 = *(const u32x4*)(Z + (size_t)(r0 - 2) * DM + c8);
#pragma unroll
        for (int h = 0; h < 2; ++h) {
            u32x4 zz[8], bb[8];
#pragma unroll
            for (int i = 0; i < 8; ++i) { zz[i] = *(const u32x4*)(Z + (size_t)(r0 + 8 * h + i) * DM + c8); bb[i] = *(const u32x4*)(Bg + (size_t)(r0 + 8 * h + i) * DM + c8); }
#pragma unroll
            for (int i = 0; i < 8; ++i) {
                const u32x4 z0 = zz[i], bg = bb[i]; u32x4 o;
#pragma unroll
                for (int j = 0; j < 4; ++j) {
                    const float lo = bf_lo(bg[j]) * (k0[2 * j] * bf_lo(z2[j]) + k1[2 * j] * bf_lo(z1[j]) + k2[2 * j] * bf_lo(z0[j]));
                    const float hi = bf_hi(bg[j]) * (k0[2 * j + 1] * bf_hi(z2[j]) + k1[2 * j + 1] * bf_hi(z1[j]) + k2[2 * j + 1] * bf_hi(z0[j]));
                    o[j] = cvtpk(lo, hi);
                }
                *(u32x4*)(Y + (size_t)(r0 + 8 * h + i) * DM + c8) = o;
                z2 = z1; z1 = z0;
            }
        }
    }
}

__device__ __forceinline__ void cmp_finalize_phase(const Frame& F, const bf16_t* slab, const float* bias1p  , const float* w2k, const float* w2v, bf16_t* KC, bf16_t* VC) {
    LAS float* bpart = (LAS float*)(F.lds);
    LAS unsigned char* hid = F.lds + 8192;
    const int w = F.wave;
    for (int it = F.vcu; it < 256; it += F.G) {
        int ln = F.lane; asm volatile("" : "+v"(ln));
        const int kv = it >> 7, row0 = (it & 127) * 16;
        __syncthreads();
        u32x2 hv[2][8];
#pragma unroll
        for (int rr = 0; rr < 2; ++rr)
#pragma unroll
            for (int ks = 0; ks < 8; ++ks) hv[rr][ks] = *(const u32x2*)(slab + ((size_t)(ks * 2 + kv) * 2048 + row0 + 2 * w + rr) * 256 + 4 * ln);
        { f32x4 bs = (f32x4){0.f, 0.f, 0.f, 0.f};
#pragma unroll
          for (int c = 0; c < 8; ++c) bs += *(const f32x4*)(bias1p + ((size_t)kv * 64 + 8 * w + c) * 256 + 4 * ln);
          *(LAS f32x4*)(bpart + w * 256 + 4 * ln) = bs; }
        const float* w2 = (kv ? w2v : w2k) + 16 * w + (ln & 15) + (size_t)(8 * (ln >> 4)) * 128;
        float wf[8][8];
#pragma unroll
        for (int s_ = 0; s_ < 8; ++s_)
#pragma unroll
            for (int j = 0; j < 8; ++j) wf[s_][j] = w2[(size_t)(32 * s_ + j) * 128];
        __syncthreads();
        f32x4 bias = (f32x4){0.f, 0.f, 0.f, 0.f};
#pragma unroll
        for (int c = 0; c < 8; ++c) bias += *(const LAS f32x4*)(bpart + c * 256 + 4 * ln);
#pragma unroll
        for (int rr = 0; rr < 2; ++rr) {
            f32x4 h = bias;
#pragma unroll
            for (int ks = 0; ks < 8; ++ks) { h[0] += bf_lo(hv[rr][ks].x); h[1] += bf_hi(hv[rr][ks].x); h[2] += bf_lo(hv[rr][ks].y); h[3] += bf_hi(hv[rr][ks].y); }
            u32x2 o; o.x = cvtpk(gelu_tanh(h[0]), gelu_tanh(h[1])); o.y = cvtpk(gelu_tanh(h[2]), gelu_tanh(h[3]));
            *(LAS u32x2*)(hid + (2 * w + rr) * 528 + 8 * ln) = o;
        }
        __syncthreads();
        f32x4 acc = (f32x4){0.f, 0.f, 0.f, 0.f};
        const int fr = ln & 15, fq = ln >> 4;
#pragma unroll
        for (int s_ = 0; s_ < 8; ++s_) {
            const bf16x8 hf = *(const LAS bf16x8*)(hid + fr * 528 + 64 * s_ + 16 * fq);
            u32x4 wp; wp.x = cvtpk(wf[s_][0], wf[s_][1]); wp.y = cvtpk(wf[s_][2], wf[s_][3]); wp.z = cvtpk(wf[s_][4], wf[s_][5]); wp.w = cvtpk(wf[s_][6], wf[s_][7]);
            acc = __builtin_amdgcn_mfma_f32_16x16x32_bf16(__builtin_bit_cast(bf16x8, wp), hf, acc, 0, 0, 0);
        }
        const int row = row0 + fr;
        u32x2 o; o.x = cvtpk(acc[0], acc[1]); o.y = cvtpk(acc[2], acc[3]);
        if ((row & 255) == 255) o = (u32x2){0u, 0u};
        *(u32x2*)((kv ? VC : KC) + (size_t)row * 128 + 16 * w + 4 * fq) = o;
    }
}

namespace att {
constexpr int KS0 = 0  , VS0 = 32768  , STG = 81920, STGW = 32 * 272, IMPA = STG, IMPC = STG + 16384  , MASK = STG + 8 * STGW, LUT = MASK + 512;
static_assert(LUT + 2048 <= RING_BYTES && IMPC + 16384 <= MASK, "attention LDS");
constexpr float NEG = -1e30f, DEFER_THR = 8.0f;
__device__ __forceinline__ unsigned off_a(unsigned row, unsigned ch) { return 2048u * (row >> 3) + 512u * (ch >> 2) + 64u * (row & 7u) + 16u * ((ch & 3u) ^ ((row >> 2) & 3u)); }
__device__ __forceinline__ s16x4 vtr(const LAS unsigned char* p) { return __builtin_bit_cast(s16x4, __builtin_amdgcn_ds_read_tr16_b64_v4i16((LAS v4i16_t*)p)); }
__device__ __forceinline__ int t5_bucket(int d) {
    if (d < 16) return d;
    int b = 16;
    b += d >= 19; b += d >= 21; b += d >= 24; b += d >= 27; b += d >= 31; b += d >= 35; b += d >= 40; b += d >= 46; b += d >= 52; b += d >= 59; b += d >= 67; b += d >= 77; b += d >= 87; b += d >= 99; b += d >= 113;
    return b;
}
__device__ __forceinline__ unsigned dma_src_off(unsigned s) {
    const unsigned rhi = s >> 7, chi = (s >> 5) & 3u, rlo = (s >> 2) & 7u, cx = s & 3u, row = (rhi << 3) | rlo, x = ((row >> 2) & 3u), ch = (chi << 2) | (cx ^ x);
    return row * 256u + ch * 16u;
}
template <bool WITHV> __device__ __forceinline__ void tile_dma(LAS unsigned char* lds, int ks, int vs, const bf16_t* kb, const bf16_t* vb, const unsigned (&goff)[2], int w) {
#pragma unroll
    for (int i = 0; i < 2; ++i) {
        __builtin_amdgcn_global_load_lds((const unsigned*)((const char*)kb + goff[i]), (LAS unsigned*)(lds + KS0 + ks * 16384 + (8 * i + w) * 1024), 16, 0, 0);
        if (WITHV) __builtin_amdgcn_global_load_lds((const unsigned*)((const char*)vb + goff[i]), (LAS unsigned*)(lds + VS0 + vs * 16384 + (8 * i + w) * 1024), 16, 0, 0);
    }
}
#define ATT_WAITBAR() asm volatile("s_waitcnt vmcnt(0) lgkmcnt(0)\n\ts_barrier" ::: "memory")
__device__ __forceinline__ void qk_tiles(f32x16& s0, f32x16& s1, const LAS unsigned char* lds, const bf16x8 (&qf)[8], int lane) {
    const unsigned r32 = lane & 31, hh = lane >> 5;
    const unsigned b0 = 2048u * (r32 >> 3) + 64u * (r32 & 7u) + 16u * ((0u + hh) ^ ((r32 >> 2) & 3u)), b1 = 2048u * (r32 >> 3) + 64u * (r32 & 7u) + 16u * ((2u + hh) ^ ((r32 >> 2) & 3u));
    bf16x8 k0[8], k1[8];
#pragma unroll
    for (int ks = 0; ks < 8; ++ks) k0[ks] = *(const LAS bf16x8*)(lds + ((ks & 1) ? b1 : b0) + 512u * (ks >> 1));
#pragma unroll
    for (int ks = 0; ks < 4; ++ks) k1[ks] = *(const LAS bf16x8*)(lds + ((ks & 1) ? b1 : b0) + 8192u + 512u * (ks >> 1));
    __builtin_amdgcn_sched_barrier(0);
#pragma unroll
    for (int i = 0; i < 16; ++i) { s0[i] = 0.f; s1[i] = 0.f; }
#pragma unroll
    for (int ks = 0; ks < 8; ++ks) s0 = __builtin_amdgcn_mfma_f32_32x32x16_bf16(k0[ks], qf[ks], s0, 0, 0, 0);
    __builtin_amdgcn_sched_barrier(0);
#pragma unroll
    for (int ks = 4; ks < 8; ++ks) k1[ks] = *(const LAS bf16x8*)(lds + ((ks & 1) ? b1 : b0) + 8192u + 512u * (ks >> 1));
#pragma unroll
    for (int ks = 0; ks < 8; ++ks) s1 = __builtin_amdgcn_mfma_f32_32x32x16_bf16(k1[ks], qf[ks], s1, 0, 0, 0);
    __builtin_amdgcn_sched_barrier(0);
}
__device__ __forceinline__ bf16x8 pack8(const f32x16& p, int s) {
    u32x4 w; w.x = cvtpk(p[8 * s + 0], p[8 * s + 1]); w.y = cvtpk(p[8 * s + 2], p[8 * s + 3]); w.z = cvtpk(p[8 * s + 4], p[8 * s + 5]); w.w = cvtpk(p[8 * s + 6], p[8 * s + 7]);
    return __builtin_bit_cast(bf16x8, w);
}
__device__ __forceinline__ void pack_p(bf16x8 (&pf)[4], const f32x16& p0, const f32x16& p1) {
#pragma unroll
    for (int c = 0; c < 4; ++c) pf[c] = pack8((c >> 1) ? p1 : p0, c & 1);
}
__device__ __forceinline__ void pv_mma(f32x16 (&O)[4], const LAS unsigned char* vt, const bf16x8 (&pf)[4], int lane) {
    const unsigned hh = lane >> 5, blk = (lane >> 4) & 1, q = (lane & 15) >> 2, p = lane & 3;
    const unsigned bv0 = 64u * (4u * hh + q) + 16u * ((2u * blk + (p >> 1)) ^ ((0u + hh) & 3u)) + 8u * (p & 1u);
    const unsigned bv1 = 64u * (4u * hh + q) + 16u * ((2u * blk + (p >> 1)) ^ ((2u + hh) & 3u)) + 8u * (p & 1u);
#pragma unroll
    for (int h2 = 0; h2 < 2; ++h2) {
        bf16x8 va[2][4];
#pragma unroll
        for (int c = 0; c < 2; ++c)
#pragma unroll
            for (int dt = 0; dt < 4; ++dt) { const s16x4 lo = vtr(vt + bv0 + 2048u * (2 * (c + 2 * h2)) + 512u * dt), hi = vtr(vt + bv1 + 2048u * (2 * (c + 2 * h2) + 1) + 512u * dt); va[c][dt] = __builtin_shufflevector(lo, hi, 0, 1, 2, 3, 4, 5, 6, 7); }
        __builtin_amdgcn_sched_barrier(0);
#pragma unroll
        for (int c = 0; c < 2; ++c)
#pragma unroll
            for (int dt = 0; dt < 4; ++dt) O[dt] = __builtin_amdgcn_mfma_f32_32x32x16_bf16(va[c][dt], pf[c + 2 * h2], O[dt], 0, 0, 0);
        __builtin_amdgcn_sched_barrier(0);
    }
}
__device__ __forceinline__ float xmax32(float v) { auto rr = __builtin_amdgcn_permlane32_swap(__float_as_uint(v), __float_as_uint(v), false, false); return __builtin_fmaxf(__uint_as_float(rr[0]), __uint_as_float(rr[1])); }
__device__ __forceinline__ float xsum32(float v) { auto rr = __builtin_amdgcn_permlane32_swap(__float_as_uint(v), __float_as_uint(v), false, false); return __uint_as_float(rr[0]) + __uint_as_float(rr[1]); }
__device__ __forceinline__ int crow(int reg, int hh) { return (reg & 3) + 8 * (reg >> 2) + 4 * hh; }

template <int BR> __device__ __forceinline__ void tile_fix(f32x16& s, int pos0, int tq, int hh, bool near, bool masked, bool lanesel, const LAS float* lut) {
    if (near || masked) {
        constexpr int STEP = BR == 0 ? 16 : 1;
        int d0 = tq - (BR == 0 ? 16 * pos0 + 31 : pos0) - STEP * 4 * hh;
        asm volatile("" : "+v"(d0));
#pragma unroll
        for (int i = 0; i < 16; ++i) {
            const int dist = d0 - STEP * ((i & 3) + 8 * (i >> 2));
            bool ok = dist >= 0; if (BR == 2) ok = ok && dist < 512; if (BR == 1) ok = ok && lanesel;
            float v = s[i];
            if (near) { const int dc = dist < 0 ? 0 : (dist > 127 ? 127 : dist); v += lut[dc]; }
            s[i] = ok ? v : NEG;
        }
    }
}

template <int BR> __device__ __forceinline__ void online_front(f32x16 (&O)[4], float& m, float& l, bf16x8 (&pf)[4], const LAS unsigned char* kt, const bf16x8 (&qf)[8], int lane, int pos0, int tq, bool near, bool masked, bool lanesel, const LAS float* lut) {
    const int hh = lane >> 5;
    f32x16 s0, s1; qk_tiles(s0, s1, kt, qf, lane);
    tile_fix<BR>(s0, pos0, tq, hh, near, masked, true, lut); tile_fix<BR>(s1, pos0 + 32, tq, hh, near, masked, true, lut);
    float mx = NEG;
#pragma unroll
    for (int i = 0; i < 16; ++i) { mx = __builtin_fmaxf(mx, s0[i]); mx = __builtin_fmaxf(mx, s1[i]); }
    mx = lanesel ? mx : NEG;
    mx = xmax32(mx);
    const bool grow = mx > m + DEFER_THR;
    if (__any(grow)) {
        const float mn = grow ? mx : m, alpha = __builtin_amdgcn_exp2f(m - mn); m = mn; l *= alpha;
#pragma unroll
        for (int dt = 0; dt < 4; ++dt)
#pragma unroll
            for (int i = 0; i < 16; ++i) O[dt][i] *= alpha;
    }
    const float mu = lanesel ? __builtin_fmaxf(m, -1e20f) : 1e30f;
    float ps = 0.f;
#pragma unroll
    for (int i = 0; i < 16; ++i) { s0[i] = __builtin_amdgcn_exp2f(s0[i] - mu); s1[i] = __builtin_amdgcn_exp2f(s1[i] - mu); ps += s0[i] + s1[i]; }
    l += ps;
    pack_p(pf, s0, s1);
}

__device__ __forceinline__ unsigned stg_off(int row, int dt, int rg, int hh) { return (unsigned)row * 272u + (unsigned)((4 * dt + rg) * 16) + 8u * hh; }
template <bool ACCUM> __device__ __forceinline__ void stage_out(LAS unsigned char* stg, const f32x16 (&O)[4], float scale, int lane) {
    const int row = lane & 31, hh = lane >> 5;
#pragma unroll
    for (int dt = 0; dt < 4; ++dt)
#pragma unroll
        for (int rg = 0; rg < 4; ++rg) {
            LAS u32x2* p = (LAS u32x2*)(stg + stg_off(row, dt, rg, hh));
            float a0 = O[dt][4 * rg] * scale, a1 = O[dt][4 * rg + 1] * scale, a2 = O[dt][4 * rg + 2] * scale, a3 = O[dt][4 * rg + 3] * scale;
            if (ACCUM) { const u32x2 old = *p; a0 += bf_lo(old.x); a1 += bf_hi(old.x); a2 += bf_lo(old.y); a3 += bf_hi(old.y); }
            u32x2 w; w.x = cvtpk(a0, a1); w.y = cvtpk(a2, a3); *p = w;
        }
}

template <int SKIP> __device__ __forceinline__ void attn_phase(const Frame& F, const bf16_t* Q, const bf16_t* KV, const bf16_t* KC, const bf16_t* VC, const float* gates, const float* rel_bias, bf16_t* Oout) {
    LAS unsigned char* lds = F.lds;
    const int tid = F.tid, lane = F.lane, w = F.wave, hh = lane >> 5, qrow = lane & 31, ql = qrow >> 2, r = qrow & 3;
    LAS float* impA = (LAS float*)(lds + IMPA); LAS float* impC = (LAS float*)(lds + IMPC);
    LAS unsigned char* maskb = lds + MASK; LAS float* lutall = (LAS float*)(lds + LUT);
    LAS unsigned char* stg = lds + STG + w * STGW;
#define SEC_BEGIN ln = lane; asm volatile("" : "+v"(ln)); td = w * 64 + ln
    const int nun = F.G == 256 ? 2 : (512 - (int)blockIdx.x + F.G - 1) / F.G;
    for (int ui = 0; ui < nun; ++ui) {
        const int unit = F.G == 256 ? ((int)(blockIdx.x & 7) * 64 + (ui == 0 ? 63 - (int)(blockIdx.x >> 3) : (int)(blockIdx.x >> 3))) : (int)blockIdx.x + ui * F.G;
        int ln, td;
        const int bg = unit >> 6, qi = unit & 63, b = bg >> 2, g = bg & 3, t0 = qi * 64;
        const int tq = t0 + 8 * w + ql; const size_t trow = (size_t)b * SEQ + tq; const int head = g * 4 + r;
        const bf16_t* kcb = KC + (size_t)bg * 256 * 128; const bf16_t* vcb = VC + (size_t)bg * 256 * 128;
        const bf16_t* ksb = KV + (size_t)((2 * 2 + b) * 4 + g) * 4096 * 128; const bf16_t* vsb = KV + (size_t)((3 * 2 + b) * 4 + g) * 4096 * 128;
        const bf16_t* kwb = KV + (size_t)((4 * 2 + b) * 4 + g) * 4096 * 128; const bf16_t* vwb = KV + (size_t)((5 * 2 + b) * 4 + g) * 4096 * 128;
        __syncthreads();
        SEC_BEGIN;
        unsigned goff[2];
#pragma unroll
        for (int i = 0; i < 2; ++i) goff[i] = dma_src_off((unsigned)((8 * i + w) * 64 + ln));
        int st = 0;
        tile_dma<false>(lds, st, st, kcb, nullptr, goff, w);
        { const int rr = td >> 7, d = td & 127; const int hd = g * 4 + rr; lutall[td] = (rel_bias[t5_bucket(d) * 16 + hd] - rel_bias[31 * 16 + hd]) * LOG2E; }
        for (int i = td; i < 8192; i += 512) ((LAS float*)(lds + IMPA))[i] = 0.f;
        const LAS float* lut = lutall + r * 128;
        bf16x8 qf[8];
#pragma unroll
        for (int ks = 0; ks < 8; ++ks) qf[ks] = *(const bf16x8*)(Q + trow * DM + head * 128 + 16 * ks + 8 * hh);
        const float g0 = gates[trow * 48 + head], g1 = gates[trow * 48 + 16 + head], g2 = gates[trow * 48 + 32 + head];
        const int tq_lo = t0 + 8 * w, tq_hi = tq_lo + 7;
        const int nbc = (4 * qi + 2) / 64 + 1;
        float m = NEG, l = 0.f;
        for (int jb = 0; jb < nbc; ++jb) {
            ATT_WAITBAR();
            if (jb + 1 < nbc) tile_dma<false>(lds, st ^ 1, st ^ 1, kcb + (size_t)(jb + 1) * 64 * 128, nullptr, goff, w);
            else tile_dma<true>(lds, st ^ 1, st ^ 1, kcb, vcb, goff, w);
            const LAS unsigned char* sl = lds + KS0 + st * 16384; const LAS unsigned char* vl = lds + VS0 + st * 16384; (void)vl; st ^= 1;
            const int c0 = 64 * jb;
            if (!(SKIP & 4) && 16 * c0 + 31 <= tq_hi) {
                f32x16 s0, s1; qk_tiles(s0, s1, sl, qf, ln);
                const bool near0 = tq_lo - (16 * (c0 + 31) + 31) < 113, near1 = tq_lo - (16 * (c0 + 63) + 31) < 113;
                const bool mk0 = 16 * (c0 + 31) + 31 > tq_lo, mk1 = 16 * (c0 + 63) + 31 > tq_lo;
                tile_fix<0>(s0, c0, tq, hh, near0, mk0, true, lut); tile_fix<0>(s1, c0 + 32, tq, hh, near1, mk1, true, lut);
                float mx = NEG;
#pragma unroll
                for (int i = 0; i < 16; ++i) { mx = __builtin_fmaxf(mx, s0[i]); mx = __builtin_fmaxf(mx, s1[i]); }
                mx = xmax32(mx);
                const float mn = __builtin_fmaxf(m, mx), alpha = __builtin_amdgcn_exp2f(m - mn); m = mn;
                const float mu = __builtin_fmaxf(mn, -1e20f);
                float ps = 0.f;
#pragma unroll
                for (int i = 0; i < 16; ++i) { ps += __builtin_amdgcn_exp2f(s0[i] - mu); ps += __builtin_amdgcn_exp2f(s1[i] - mu); }
                l = l * alpha + ps;
            }
        }
        l = xsum32(l);
        const float invl = l > 0.f ? 1.0f / l : 0.f;
        f32x16 O[4];
#pragma unroll
        for (int dt = 0; dt < 4; ++dt)
#pragma unroll
            for (int i = 0; i < 16; ++i) O[dt][i] = 0.f;
        SEC_BEGIN;
        for (int jb = 0; jb < nbc; ++jb) {
            ATT_WAITBAR();
            if (jb + 1 < nbc) tile_dma<true>(lds, st ^ 1, st ^ 1, kcb + (size_t)(jb + 1) * 64 * 128, vcb + (size_t)(jb + 1) * 64 * 128, goff, w);
            else tile_dma<true>(lds, st ^ 1, st ^ 1, ksb, vsb, goff, w);
            const LAS unsigned char* sl = lds + KS0 + st * 16384; const LAS unsigned char* vl = lds + VS0 + st * 16384; st ^= 1;
            const int c0 = 64 * jb;
            if (!(SKIP & 4) && 16 * c0 + 31 <= tq_hi) {
                f32x16 s0, s1; qk_tiles(s0, s1, sl, qf, ln);
                const bool near0 = tq_lo - (16 * (c0 + 31) + 31) < 113, near1 = tq_lo - (16 * (c0 + 63) + 31) < 113;
                const bool mk0 = 16 * (c0 + 31) + 31 > tq_lo, mk1 = 16 * (c0 + 63) + 31 > tq_lo;
                tile_fix<0>(s0, c0, tq, hh, near0, mk0, true, lut); tile_fix<0>(s1, c0 + 32, tq, hh, near1, mk1, true, lut);
                const float mu = __builtin_fmaxf(m, -1e20f);
#pragma unroll
                for (int i = 0; i < 16; ++i) { s0[i] = __builtin_amdgcn_exp2f(s0[i] - mu) * invl; s1[i] = __builtin_amdgcn_exp2f(s1[i] - mu) * invl; }
#pragma unroll
                for (int kt = 0; kt < 2; ++kt)
#pragma unroll
                    for (int rg = 0; rg < 4; ++rg) {
                        const f32x16& p = kt ? s1 : s0;
                        float gs = (p[4 * rg] + p[4 * rg + 1]) + (p[4 * rg + 2] + p[4 * rg + 3]); float cy = p[4 * rg + 3];
                        gs += __shfl_xor(gs, 1); gs += __shfl_xor(gs, 2); cy += __shfl_xor(cy, 1); cy += __shfl_xor(cy, 2);
                        const int j = 16 * jb + 8 * kt + 2 * rg + hh;
                        if (r == 0) { impA[(8 * w + ql) * 64 + j] = gs; if (j + 1 < 64) impC[(8 * w + ql) * 64 + j + 1] = cy; }
                    }
                { bf16x8 pfc[4]; pack_p(pfc, s0, s1); pv_mma(O, vl, pfc, ln); }
            }
        }
        __syncthreads();
        SEC_BEGIN;
        {
            for (int i = td; i < 4096; i += 512) { const int j = i & 63;
                const bool forced = (j == 0) || (j == qi) || (j == qi - 1); const float imp = impA[i] + impC[i];
                impA[i] = forced ? 1e4f : (j <= qi ? imp : -1.0f); }
            __syncthreads();
            if (w == 0) {
                const int q = ln; unsigned L[16];
#pragma unroll
                for (int s_ = 0; s_ < 16; ++s_) L[s_] = 0u;
#define TK_CE(a_, b_) do { const unsigned h_ = (a_) > (b_) ? (a_) : (b_); (b_) = (a_) > (b_) ? (b_) : (a_); (a_) = h_; } while (0)
#pragma unroll
                for (int g_ = 0; g_ < 4; ++g_) { unsigned K_[16];
#pragma unroll
                    for (int c = 0; c < 4; ++c) { const f32x4 v = *(const LAS f32x4*)(impA + q * 64 + 16 * g_ + 4 * c);
#pragma unroll
                        for (int x = 0; x < 4; ++x) { const unsigned u_ = __float_as_uint(v[x]); const unsigned o_ = (u_ & 0x80000000u) ? ~u_ : (u_ | 0x80000000u); K_[4 * c + x] = (o_ & ~0x3Fu) | (unsigned)(63 - (16 * g_ + 4 * c + x)); } }
                    TK_CE(K_[0], K_[1]); TK_CE(K_[2], K_[3]); TK_CE(K_[4], K_[5]); TK_CE(K_[6], K_[7]); TK_CE(K_[8], K_[9]); TK_CE(K_[10], K_[11]); TK_CE(K_[12], K_[13]); TK_CE(K_[14], K_[15]); TK_CE(K_[0], K_[2]); TK_CE(K_[1], K_[3]); TK_CE(K_[4], K_[6]); TK_CE(K_[5], K_[7]); TK_CE(K_[8], K_[10]); TK_CE(K_[9], K_[11]); TK_CE(K_[12], K_[14]); TK_CE(K_[13], K_[15]); TK_CE(K_[1], K_[2]); TK_CE(K_[5], K_[6]); TK_CE(K_[9], K_[10]); TK_CE(K_[13], K_[14]); TK_CE(K_[0], K_[4]); TK_CE(K_[1], K_[5]); TK_CE(K_[2], K_[6]); TK_CE(K_[3], K_[7]); TK_CE(K_[8], K_[12]); TK_CE(K_[9], K_[13]); TK_CE(K_[10], K_[14]); TK_CE(K_[11], K_[15]); TK_CE(K_[2], K_[4]); TK_CE(K_[3], K_[5]); TK_CE(K_[10], K_[12]); TK_CE(K_[11], K_[13]); TK_CE(K_[1], K_[2]); TK_CE(K_[3], K_[4]); TK_CE(K_[5], K_[6]); TK_CE(K_[9], K_[10]); TK_CE(K_[11], K_[12]); TK_CE(K_[13], K_[14]); TK_CE(K_[0], K_[8]); TK_CE(K_[1], K_[9]); TK_CE(K_[2], K_[10]); TK_CE(K_[3], K_[11]); TK_CE(K_[4], K_[12]); TK_CE(K_[5], K_[13]); TK_CE(K_[6], K_[14]); TK_CE(K_[7], K_[15]); TK_CE(K_[4], K_[8]); TK_CE(K_[5], K_[9]); TK_CE(K_[6], K_[10]); TK_CE(K_[7], K_[11]); TK_CE(K_[2], K_[4]); TK_CE(K_[3], K_[5]); TK_CE(K_[6], K_[8]); TK_CE(K_[7], K_[9]); TK_CE(K_[10], K_[12]); TK_CE(K_[11], K_[13]); TK_CE(K_[1], K_[2]); TK_CE(K_[3], K_[4]); TK_CE(K_[5], K_[6]); TK_CE(K_[7], K_[8]); TK_CE(K_[9], K_[10]); TK_CE(K_[11], K_[12]); TK_CE(K_[13], K_[14]);
#pragma unroll
                    for (int i = 0; i < 16; ++i) L[i] = L[i] > K_[15 - i] ? L[i] : K_[15 - i];
                    TK_CE(L[0], L[8]); TK_CE(L[1], L[9]); TK_CE(L[2], L[10]); TK_CE(L[3], L[11]); TK_CE(L[4], L[12]); TK_CE(L[5], L[13]); TK_CE(L[6], L[14]); TK_CE(L[7], L[15]); TK_CE(L[0], L[4]); TK_CE(L[1], L[5]); TK_CE(L[2], L[6]); TK_CE(L[3], L[7]); TK_CE(L[8], L[12]); TK_CE(L[9], L[13]); TK_CE(L[10], L[14]); TK_CE(L[11], L[15]); TK_CE(L[0], L[2]); TK_CE(L[1], L[3]); TK_CE(L[4], L[6]); TK_CE(L[5], L[7]); TK_CE(L[8], L[10]); TK_CE(L[9], L[11]); TK_CE(L[12], L[14]); TK_CE(L[13], L[15]); TK_CE(L[0], L[1]); TK_CE(L[2], L[3]); TK_CE(L[4], L[5]); TK_CE(L[6], L[7]); TK_CE(L[8], L[9]); TK_CE(L[10], L[11]); TK_CE(L[12], L[13]); TK_CE(L[14], L[15]); }
#undef TK_CE
                unsigned long long bits = 0ull;
#pragma unroll
                for (int s_ = 0; s_ < 16; ++s_) bits |= 1ull << (63u - (L[s_] & 63u));
                *(LAS unsigned long long*)(maskb + q * 8) = bits;
            }
            __syncthreads();
        }
        stage_out<false>(stg, O, g0, ln);
        const unsigned long long causal_mask = qi >= 63 ? ~0ull : ((2ull << qi) - 1ull);
        const unsigned long long mymask = *(const LAS unsigned long long*)(maskb + (8 * w + ql) * 8) & causal_mask;
        unsigned long long uni = *(const LAS unsigned long long*)(maskb + (ln & 63) * 8) & causal_mask;
#pragma unroll
        for (int o = 1; o < 64; o <<= 1) { const unsigned lo = __shfl_xor((unsigned)uni, o), hi = __shfl_xor((unsigned)(uni >> 32), o); uni |= ((unsigned long long)hi << 32) | lo; }
        unsigned long long wuni = mymask;
#pragma unroll
        for (int o = 4; o < 32; o <<= 1) { const unsigned lo = __shfl_xor((unsigned)wuni, o), hi = __shfl_xor((unsigned)(wuni >> 32), o); wuni |= ((unsigned long long)hi << 32) | lo; }
        uni = ((unsigned long long)__builtin_amdgcn_readfirstlane((unsigned)(uni >> 32)) << 32) | (unsigned)__builtin_amdgcn_readfirstlane((unsigned)uni);
        wuni = ((unsigned long long)__builtin_amdgcn_readfirstlane((unsigned)(wuni >> 32)) << 32) | (unsigned)__builtin_amdgcn_readfirstlane((unsigned)wuni);
        const int jlo = qi >= 8 ? qi - 8 : 0;
#define ATT_STEP(BR_, need_, pos0_, near_, masked_, lanesel_) do { \
            const LAS unsigned char* kt_ = lds + KS0 + kc * 16384; const LAS unsigned char* vt_ = lds + VS0 + vc * 16384; \
            int lq = ln; asm volatile("" : "+v"(lq));     \
            if (!late_c) { if (need_) { bf16x8 pf_[4]; online_front<BR_>(O, m, l, pf_, kt_, qf, lq, pos0_, tq, near_, masked_, lanesel_, lut); pv_mma(O, vt_, pf_, lq); } } \
            else { if (pend) pv_mma(O, lds + VS0 + vprev * 16384, pfl, lq); \
                   if (need_) online_front<BR_>(O, m, l, pfl, kt_, qf, lq, pos0_, tq, near_, masked_, lanesel_, lut); \
                   pend = (need_); vprev = vc; } \
            kc ^= 1; vc = vc == 2 ? 0 : vc + 1; } while (0)
#define ATT_FLUSH() do { if (late_c && pend) { int lq = ln; asm volatile("" : "+v"(lq)); pv_mma(O, lds + VS0 + vprev * 16384, pfl, lq); } pend = false; } while (0)
#define ATT_SELWIN(LATE_) do { constexpr bool late_c = LATE_; \
        int kc = st, vc = st; \
        bf16x8 pfl[4]; bool pend = false; int vprev = 0; \
        SEC_BEGIN; \
        { \
            m = NEG; l = 0.f; \
_Pragma("unroll") \
            for (int dt = 0; dt < 4; ++dt) \
_Pragma("unroll") \
                for (int i = 0; i < 16; ++i) O[dt][i] = 0.f; \
            unsigned long long rem = uni; \
            int j = __builtin_ctzll(rem); rem &= rem - 1; \
            for (;;) { \
                ATT_WAITBAR(); \
                const int jn = rem ? __builtin_ctzll(rem) : -1; \
                const int kn = kc ^ 1, vn = vc == 2 ? 0 : vc + 1; \
                if (jn >= 0) { rem &= rem - 1; tile_dma<true>(lds, kn, vn, ksb + (size_t)jn * 64 * 128, vsb + (size_t)jn * 64 * 128, goff, w); } \
                else tile_dma<true>(lds, kn, vn, kwb + (size_t)jlo * 64 * 128, vwb + (size_t)jlo * 64 * 128, goff, w); \
                const bool need = !(SKIP & 1) && ((wuni >> j) & 1ull); const bool lanesel = (mymask >> j) & 1ull; \
                ATT_STEP(1, need, 64 * j, j >= qi - 2, j == qi, lanesel); \
                if (jn < 0) break; \
                j = jn; \
            } \
            ATT_FLUSH(); \
            l = xsum32(l); \
            stage_out<true>(stg, O, l > 0.f ? g1 / l : 0.f, ln); \
        } \
        SEC_BEGIN; \
        { \
            m = NEG; l = 0.f; \
_Pragma("unroll") \
            for (int dt = 0; dt < 4; ++dt) \
_Pragma("unroll") \
                for (int i = 0; i < 16; ++i) O[dt][i] = 0.f; \
            for (int j = jlo; j <= qi; ++j) { \
                ATT_WAITBAR(); \
                const int kn = kc ^ 1, vn = vc == 2 ? 0 : vc + 1; \
                if (j + 1 <= qi) tile_dma<true>(lds, kn, vn, kwb + (size_t)(j + 1) * 64 * 128, vwb + (size_t)(j + 1) * 64 * 128, goff, w); \
                const bool masked = (j == qi) || (j == qi - 8); const bool need = !(SKIP & 2); \
                ATT_STEP(2, need, 64 * j, j >= qi - 2, masked, true); \
            } \
            ATT_FLUSH(); \
            l = xsum32(l); \
            stage_out<true>(stg, O, l > 0.f ? g2 / l : 0.f, ln); \
        } \
        } while (0)
        if (w >= 4) ATT_SELWIN(true); else ATT_SELWIN(false);
#undef ATT_SELWIN
#undef ATT_STEP
#undef ATT_FLUSH
        SEC_BEGIN;
        LDS_WAIT(); asm volatile("" ::: "memory");
#pragma unroll
        for (int i = 0; i < 8; ++i) {
            const int idx = ln + 64 * i, row = idx >> 4, ch = idx & 15;
            const u32x4 v = *(const LAS u32x4*)(stg + row * 272 + ch * 16);
            const int rql = row >> 2, rr = row & 3;
            *(u32x4*)(Oout + ((size_t)b * SEQ + t0 + 8 * w + rql) * DM + (g * 4 + rr) * 128 + ch * 8) = v;
        }
    }
}
#undef SEC_BEGIN
}


__device__ __forceinline__ void xcd_align(unsigned* cnt, unsigned nloc, int wave, int lane) {
    asm volatile("" ::: "memory"); __builtin_amdgcn_s_barrier(); asm volatile("" ::: "memory");
    if (wave == 0) {
        if (lane == 0) { (void)__hip_atomic_fetch_add(cnt, 1u, RLX_AGENT); }
        unsigned sp = 0u;
        while ((unsigned)__builtin_amdgcn_readfirstlane((int)__hip_atomic_load(cnt, RLX_AGENT)) < nloc) { __builtin_amdgcn_s_sleep(1); if (++sp > 40000u) break; }
    }
    asm volatile("" ::: "memory"); __builtin_amdgcn_s_barrier(); asm volatile("" ::: "memory");
}
namespace peer {
constexpr int LISTS = 0, IDXO = 90112, GATEO = 106496, SUO = 122880;
constexpr int XQO = 0, KEYO = 65536, HISTO = 81920, SXO = 86016;
static_assert(SUO + 16384 <= RING_BYTES && SXO + 256 + 2048 <= IDXO, "PEER tail LDS map");
__device__ __forceinline__ unsigned ford(float f) { const unsigned u = __float_as_uint(f); return (u & 0x80000000u) ? ~u : (u | 0x80000000u); }
__device__ __forceinline__ float finv(unsigned k) { return __uint_as_float((k & 0x80000000u) ? (k & 0x7fffffffu) : ~k); }
#define INS16(L, x) do { unsigned _x = (x); _Pragma("unroll") for (int _s = 0; _s < 16; ++_s) { const unsigned _h = L[_s] > _x ? L[_s] : _x; _x = L[_s] > _x ? _x : L[_s]; L[_s] = _h; } } while (0)

template <int TSKIP> __device__ __forceinline__ void tail_phase(const Frame& F, const Args& a, int layer, const bf16_t* SC, const float* H, const float* ssq, float* Ho, bf16_t* Hb, float* ssqo, float* outp, const unsigned char* Ub, const unsigned char* Vb, const float* Usc, const float* Vsc, unsigned* align_cnt, unsigned nloc) {
    LAS unsigned char* lds = F.lds; const int w = F.wave;
    LAS float* sc = (LAS float*)lds; LAS unsigned* lists = (LAS unsigned*)(lds + LISTS); LAS int* idxs = (LAS int*)(lds + IDXO); LAS float* gts = (LAS float*)(lds + GATEO); LAS float* sus = (LAS float*)(lds + SUO);
    const float* gain = a.ffn_norm + (size_t)layer * DM;
    for (int tile = blockIdx.x; tile < T / 32; tile += F.G) {
        const int t0 = tile * 32;
        int lane = F.lane; asm volatile("" : "+v"(lane)); const int tid = w * 64 + lane;
        unsigned L[16];
#pragma unroll
        for (int s = 0; s < 16; ++s) L[s] = 0u;
#define TK_CE(a_, b_) do { const unsigned h_ = (a_) > (b_) ? (a_) : (b_); (b_) = (a_) > (b_) ? (b_) : (a_); (a_) = h_; } while (0)
#define TK_SCAN() do { _Pragma("unroll") for (int g = 0; g < ((TSKIP & 4) ? 0 : 8); ++g) { unsigned K_[16]; \
            _Pragma("unroll") for (int i = 0; i < 8; ++i) { const unsigned dw = scw[tid * 65 + 8 * g + i]; \
                K_[2 * i] = (ford(bf_lo(dw)) & ~0x7Fu) | (unsigned)(127 - (16 * g + 2 * i)); K_[2 * i + 1] = (ford(bf_hi(dw)) & ~0x7Fu) | (unsigned)(127 - (16 * g + 2 * i + 1)); } \
            SORT_NET \
            _Pragma("unroll") for (int i = 0; i < 16; ++i) L[i] = L[i] > K_[15 - i] ? L[i] : K_[15 - i]; \
            BITONIC_NET } } while (0)
#define SORT_NET TK_CE(K_[0], K_[1]); TK_CE(K_[2], K_[3]); TK_CE(K_[4], K_[5]); TK_CE(K_[6], K_[7]); TK_CE(K_[8], K_[9]); TK_CE(K_[10], K_[11]); TK_CE(K_[12], K_[13]); TK_CE(K_[14], K_[15]); TK_CE(K_[0], K_[2]); TK_CE(K_[1], K_[3]); TK_CE(K_[4], K_[6]); TK_CE(K_[5], K_[7]); TK_CE(K_[8], K_[10]); TK_CE(K_[9], K_[11]); TK_CE(K_[12], K_[14]); TK_CE(K_[13], K_[15]); TK_CE(K_[1], K_[2]); TK_CE(K_[5], K_[6]); TK_CE(K_[9], K_[10]); TK_CE(K_[13], K_[14]); TK_CE(K_[0], K_[4]); TK_CE(K_[1], K_[5]); TK_CE(K_[2], K_[6]); TK_CE(K_[3], K_[7]); TK_CE(K_[8], K_[12]); TK_CE(K_[9], K_[13]); TK_CE(K_[10], K_[14]); TK_CE(K_[11], K_[15]); TK_CE(K_[2], K_[4]); TK_CE(K_[3], K_[5]); TK_CE(K_[10], K_[12]); TK_CE(K_[11], K_[13]); TK_CE(K_[1], K_[2]); TK_CE(K_[3], K_[4]); TK_CE(K_[5], K_[6]); TK_CE(K_[9], K_[10]); TK_CE(K_[11], K_[12]); TK_CE(K_[13], K_[14]); TK_CE(K_[0], K_[8]); TK_CE(K_[1], K_[9]); TK_CE(K_[2], K_[10]); TK_CE(K_[3], K_[11]); TK_CE(K_[4], K_[12]); TK_CE(K_[5], K_[13]); TK_CE(K_[6], K_[14]); TK_CE(K_[7], K_[15]); TK_CE(K_[4], K_[8]); TK_CE(K_[5], K_[9]); TK_CE(K_[6], K_[10]); TK_CE(K_[7], K_[11]); TK_CE(K_[2], K_[4]); TK_CE(K_[3], K_[5]); TK_CE(K_[6], K_[8]); TK_CE(K_[7], K_[9]); TK_CE(K_[10], K_[12]); TK_CE(K_[11], K_[13]); TK_CE(K_[1], K_[2]); TK_CE(K_[3], K_[4]); TK_CE(K_[5], K_[6]); TK_CE(K_[7], K_[8]); TK_CE(K_[9], K_[10]); TK_CE(K_[11], K_[12]); TK_CE(K_[13], K_[14]);
#define BITONIC_NET TK_CE(L[0], L[8]); TK_CE(L[1], L[9]); TK_CE(L[2], L[10]); TK_CE(L[3], L[11]); TK_CE(L[4], L[12]); TK_CE(L[5], L[13]); TK_CE(L[6], L[14]); TK_CE(L[7], L[15]); TK_CE(L[0], L[4]); TK_CE(L[1], L[5]); TK_CE(L[2], L[6]); TK_CE(L[3], L[7]); TK_CE(L[8], L[12]); TK_CE(L[9], L[13]); TK_CE(L[10], L[14]); TK_CE(L[11], L[15]); TK_CE(L[0], L[2]); TK_CE(L[1], L[3]); TK_CE(L[4], L[6]); TK_CE(L[5], L[7]); TK_CE(L[8], L[10]); TK_CE(L[9], L[11]); TK_CE(L[12], L[14]); TK_CE(L[13], L[15]); TK_CE(L[0], L[1]); TK_CE(L[2], L[3]); TK_CE(L[4], L[5]); TK_CE(L[6], L[7]); TK_CE(L[8], L[9]); TK_CE(L[10], L[11]); TK_CE(L[12], L[13]); TK_CE(L[14], L[15]);
        {
            LAS unsigned* scw = (LAS unsigned*)lds;
            u32x4 scv[16];
#pragma unroll
            for (int k = 0; k < 16; ++k) { const int f = tid + 512 * k, tok = f >> 8, hp = (f >> 4) & 15, q = f & 15; scv[k] = *(const u32x4*)(SC + (size_t)(t0 + tok) * DM + hp * 128 + 8 * q); }
            __syncthreads();
#pragma unroll
            for (int k = 0; k < 16; ++k) { const int f = tid + 512 * k, tok = f >> 8, hp = (f >> 4) & 15, q = f & 15; LAS unsigned* d = scw + (tok * 16 + hp) * 65 + 4 * q; d[0] = scv[k][0]; d[1] = scv[k][1]; d[2] = scv[k][2]; d[3] = scv[k][3]; }
            __syncthreads();
            TK_SCAN();
        }
#undef SORT_NET
#undef BITONIC_NET
#undef TK_CE
#undef TK_SCAN
        __syncthreads();
#pragma unroll
        for (int s = 0; s < 16; ++s) lists[tid * 17 + s] = L[s];
        __syncthreads();
        if (tid < 256 && !(TSKIP & 16)) {
            const int tok = tid >> 3, h = tid & 7; const int ta = (tok * 16 + h * 2) * 17, tb = ta + 17;
            float s1[16], s2[16];
#pragma unroll
            for (int s = 0; s < 16; ++s) { s1[s] = finv(lists[ta + s] & ~0x7Fu); s2[s] = finv(lists[tb + s] & ~0x7Fu); }
            unsigned C[16];
#pragma unroll
            for (int s = 0; s < 16; ++s) C[s] = 0u;
#pragma unroll
            for (int x = 0; x < 16; ++x)
#pragma unroll
                for (int y = 0; y < 16; ++y) if ((x + 1) * (y + 1) <= 16) { const unsigned key = (ford(s1[x] + s2[y]) & ~0xFFu) | (unsigned)(255 - (x * 16 + y)); INS16(C, key); }
            float ts[16]; float sum = 0.f; const float mx = finv(C[0] & ~0xFFu);
#pragma unroll
            for (int s = 0; s < 16; ++s) { ts[s] = __builtin_amdgcn_exp2f((finv(C[s] & ~0xFFu) - mx) * LOG2E); sum += ts[s]; }
            const float inv = 1.0f / sum;
#pragma unroll
            for (int s = 0; s < 16; ++s) { const int pos = 255 - (int)(C[s] & 0xFFu), x = pos >> 4, y = pos & 15;
                const int i1 = 127 - (int)(lists[ta + x] & 0x7Fu), i2 = 127 - (int)(lists[tb + y] & 0x7Fu);
                const int e = i1 * 128 + i2; idxs[tok * 128 + h * 16 + s] = e; gts[tok * 128 + h * 16 + s] = ts[s] * inv * Vsc[e] * 256.0f; sus[tok * 128 + h * 16 + s] = Usc[e]; }
        }
        __syncthreads();
        LAS unsigned char* xql = lds + XQO; LAS float* sxl = (LAS float*)(lds + SXO); LAS unsigned* keys = (LAS unsigned*)(lds + KEYO); LAS unsigned* hist = (LAS unsigned*)(lds + HISTO);
        f32x4 hpre[4][8]; float ppre[4];
#pragma unroll
        for (int it4 = 0; it4 < 4; ++it4) { const size_t t = (size_t)t0 + w + 8 * it4;
#pragma unroll
            for (int m = 0; m < 8; ++m) hpre[it4][m] = *(const f32x4*)(H + t * DM + 256 * m + 4 * lane);
            ppre[it4] = lane < 32 ? ssq[t * 32 + lane] : 0.f; }
        f32x4 gpre[8];
#pragma unroll
        for (int m = 0; m < 8; ++m) gpre[m] = *(const f32x4*)(gain + 256 * m + 4 * lane);
#pragma unroll
        for (int it4 = 0; it4 < ((TSKIP & 8) ? 0 : 4); ++it4) {
            const int tl = w + 8 * it4;
            int ln = lane; asm volatile("" : "+v"(ln));
            float pss = ppre[it4]; pss = wave_sum(pss);
            const float rstd = rsqrtf(pss * (1.0f / DM) + EPS);
            {
                float xv[2][16]; float am = 0.f;
#pragma unroll
                for (int j = 0; j < 2; ++j)
#pragma unroll
                    for (int i = 0; i < 4; ++i) { const f32x4 h4 = hpre[it4][i + 4 * j], g4 = gpre[i + 4 * j];
#pragma unroll
                        for (int c = 0; c < 4; ++c) { xv[j][4 * i + c] = h4[c] * rstd * g4[c]; am = __builtin_fmaxf(am, __builtin_fabsf(xv[j][4 * i + c])); } }
                am = __builtin_fmaxf(am, dpp_f<0xB1>(am)); am = __builtin_fmaxf(am, dpp_f<0x4E>(am)); am = __builtin_fmaxf(am, dpp_f<0x141>(am)); am = __builtin_fmaxf(am, dpp_f<0x140>(am));
                am = __builtin_fmaxf(__builtin_fmaxf(__builtin_bit_cast(float, __builtin_amdgcn_readlane(__builtin_bit_cast(int, am), 0)), __builtin_bit_cast(float, __builtin_amdgcn_readlane(__builtin_bit_cast(int, am), 16))),
                                     __builtin_fmaxf(__builtin_bit_cast(float, __builtin_amdgcn_readlane(__builtin_bit_cast(int, am), 32)), __builtin_bit_cast(float, __builtin_amdgcn_readlane(__builtin_bit_cast(int, am), 48))));
                const float qs = am > 0.f ? 119.0f / am : 1.0f;
                if (ln == 0) sxl[tl] = am > 0.f ? am * (1.0f / 119.0f) : 1.0f;
                float sx = 0.f; u32x4 ph, pl;
#pragma unroll
                for (int i = 0; i < 4; ++i) { unsigned wh = 0u, wl = 0u;
#pragma unroll
                    for (int c = 0; c < 4; ++c) { const int x0 = (int)__builtin_rintf(xv[0][4 * i + c] * qs), x1 = (int)__builtin_rintf(xv[1][4 * i + c] * qs); sx += (float)(x0 + x1);
                        const int l0 = ((x0 + 8) & 15) - 8, l1 = ((x1 + 8) & 15) - 8, h0 = (x0 - l0) >> 4, h1 = (x1 - l1) >> 4;
                        wh |= (((unsigned)h0 & 15u) | (((unsigned)h1 & 15u) << 4)) << (8 * c); wl |= (((unsigned)l0 & 15u) | (((unsigned)l1 & 15u) << 4)) << (8 * c); }
                    ph[i] = wh; pl[i] = wl; }
                *(LAS u32x4*)(xql + tl * 2048 + 16 * ln) = ph; *(LAS u32x4*)(xql + tl * 2048 + 1024 + 16 * ln) = pl;
                sx = wave_sum(sx);
                if (ln == 0) sxl[32 + tl] = 0.5f * sx;
            }
        }
        { int td = tid; asm volatile("" : "+v"(td)); hist[td] = 0u; }
        __syncthreads();
        {
            int td = tid; asm volatile("" : "+v"(td));
            unsigned mykey[8];
#pragma unroll
            for (int q = 0; q < 8; ++q) { const int pid = td + 512 * q; const unsigned e = (unsigned)idxs[pid]; mykey[q] = (e << 12) | (unsigned)pid; (void)__hip_atomic_fetch_add(hist + (e >> 6), 1u, __ATOMIC_RELAXED, __HIP_MEMORY_SCOPE_WORKGROUP); }
            __syncthreads();
            if (w == 0) {
                int lane_s = lane; asm volatile("" : "+v"(lane_s));
                unsigned c[4]; unsigned s4 = 0u;
#pragma unroll
                for (int k = 0; k < 4; ++k) { c[k] = hist[4 * lane_s + k]; s4 += c[k]; }
                unsigned inc = s4;
#pragma unroll
                for (int o = 1; o < 64; o <<= 1) { const unsigned up = __shfl_up(inc, o); inc += lane_s >= o ? up : 0u; }
                unsigned ex = inc - s4;
#pragma unroll
                for (int k = 0; k < 4; ++k) { hist[256 + 4 * lane_s + k] = ex; ex += c[k]; }
            }
            __syncthreads();
#pragma unroll
            for (int q = 0; q < 8; ++q) { const unsigned pos = __hip_atomic_fetch_add(hist + 256 + (mykey[q] >> 18), 1u, __ATOMIC_RELAXED, __HIP_MEMORY_SCOPE_WORKGROUP); keys[(pos & 7u) * 512u + (pos >> 3)] = mykey[q]; }
            __syncthreads();
        }
        {
            int ln = lane; asm volatile("" : "+v"(ln));
            const int c16 = (ln & 15) * 16;
            const LAS unsigned* kw = keys + w * 512 + (ln >> 4);
            const unsigned char* ubase = Ub + c16;
#define CO_KEYS(kv, b_) do { kv[0] = kw[(b_) * 8]; kv[1] = kw[(b_) * 8 + 4]; } while (0)
#define CO_LOAD(buf, kreg, kv) do { _Pragma("unroll") for (int s_ = 0; s_ < 2; ++s_) { const unsigned key = kv[s_]; kreg[s_] = key; \
        const unsigned char* ur = ((PROBE_UC && rep_ == 0) ? Vb + c16 : ubase) + (size_t)((PROBE_UF && rep_ == 0) ? (key >> 24) : (key >> 12)) * EROW; \
        _Pragma("unroll") for (int i = 0; i < 4; ++i) buf[s_][i] = *(const u32x4*)(ur + 256 * i); } } while (0)
#define CO_COMP(buf, kreg) do { _Pragma("unroll") for (int s_ = 0; s_ < 2; ++s_) { \
        const unsigned key = kreg[s_]; const int tok = (int)((key >> 7) & 31u), pid = (int)(key & 4095u); u32x4 xh_[4], xl_[4]; \
        _Pragma("unroll") for (int i = 0; i < 4; ++i) { xh_[i] = *(const LAS u32x4*)(xql + tok * 2048 + c16 + 256 * i); xl_[i] = *(const LAS u32x4*)(xql + tok * 2048 + 1024 + c16 + 256 * i); } \
        const float t_g = gts[pid], t_s = sus[pid], t_x = sxl[tok], t_o = sxl[32 + tok]; \
        __builtin_amdgcn_sched_barrier(0); \
        int di = 0, dl_ = 0; \
        _Pragma("unroll") for (int i = 0; i < 4; ++i) _Pragma("unroll") for (int k = 0; k < 4; ++k) { const int w_ = (int)buf[s_][i][k]; di = __builtin_amdgcn_sdot8(w_, (int)xh_[i][k], di, false); dl_ = __builtin_amdgcn_sdot8(w_, (int)xl_[i][k], dl_, false); }     \
        const float ev = row_sum16((float)(di * 16 + dl_)); \
        if ((ln & 15) == 0) { const float act_ = t_g * gelu_tanh((ev + t_o) * (t_s * t_x)); if (PROBE_U && rep_ == 0) ((LAS float*)(lds + SXO + 256))[pid & 511] = act_; else sus[pid] = act_; } \
        if (s_ == 0) asm volatile("" : "+v"(buf[1][0]), "+v"(buf[1][1]), "+v"(buf[1][2]), "+v"(buf[1][3])); } \
        __builtin_amdgcn_sched_barrier(0); } while (0)
            if (!(TSKIP & 1)) for (int rep_ = 0; rep_ < (PROBE_U ? 2 : 1); ++rep_) {
            u32x4 A[2][4], B[2][4]; unsigned kvA[2], kvB[2], kA[2], kB[2];
            CO_KEYS(kvA, 0); CO_KEYS(kvB, 1);
            CO_LOAD(A, kA, kvA); CO_KEYS(kvA, 2);
            for (int b = 0; b < 62; b += 2) {
                if (align_cnt && (b & 15) == 0) xcd_align(align_cnt + (b >> 3) * 64, nloc, w, lane);
                CO_LOAD(B, kB, kvB); CO_KEYS(kvB, b + 3); __builtin_amdgcn_sched_barrier(0);
                CO_COMP(A, kA);
                CO_LOAD(A, kA, kvA); CO_KEYS(kvA, (b + 4) & 63); __builtin_amdgcn_sched_barrier(0);
                CO_COMP(B, kB);
            }
            CO_LOAD(B, kB, kvB); __builtin_amdgcn_sched_barrier(0);
            CO_COMP(A, kA); __builtin_amdgcn_sched_barrier(0);
            CO_COMP(B, kB);
            }
#undef CO_KEYS
#undef CO_LOAD
#undef CO_COMP
        }
        __syncthreads();
        LAS unsigned* keysv = (LAS unsigned*)(lds + XQO);
        if (!(TSKIP & 32)) for (int s4 = 0; s4 < 4; ++s4) {
            int ln = lane; asm volatile("" : "+v"(ln));
            unsigned kq[2]; int pos[2];
#pragma unroll
            for (int q = 0; q < 2; ++q) { const int pid = (w + 8 * s4) * 128 + ln + 64 * q; kq[q] = ((unsigned)idxs[pid] << 12) | (unsigned)pid; pos[q] = 0; }
            int prefix = 0;
            for (int k = 0; k < 16; ++k) {
                int base = prefix;
#pragma unroll
                for (int q = 0; q < 2; ++q) { const bool hit = (int)(kq[q] >> 22) == k; const unsigned long long m = __ballot(hit);
                    const int r = (int)__builtin_amdgcn_mbcnt_hi((unsigned)(m >> 32), __builtin_amdgcn_mbcnt_lo((unsigned)m, 0u)); pos[q] = hit ? base + r : pos[q]; base += __popcll(m); }
                prefix = base;
            }
#pragma unroll
            for (int q = 0; q < 2; ++q) keysv[512 * w + 128 * s4 + pos[q]] = kq[q];
        }
        LDS_WAIT(); asm volatile("" ::: "memory");
        for (int pr = 0; pr < 2; ++pr) {
            int ln = lane; asm volatile("" : "+v"(ln));
            h16x2 out[2][16];
#pragma unroll
            for (int sl = 0; sl < 2; ++sl)
#pragma unroll
                for (int i = 0; i < 16; ++i) out[sl][i] = (h16x2){(_Float16)0.f, (_Float16)0.f};
            const LAS unsigned* ka = keysv + 512 * w + 256 * pr;
            f32x4 hres[2][8];
#pragma unroll
            for (int sl = 0; sl < 2; ++sl)
#pragma unroll
                for (int m = 0; m < 8; ++m) hres[sl][m] = *(const f32x4*)(H + ((size_t)t0 + w + 8 * (2 * pr + sl)) * DM + 256 * m + 4 * ln);
#define PV_KEYS(kv, b_) do { kv[0] = *(const LAS u32x4*)(ka + (b_) * 4); kv[1] = *(const LAS u32x4*)(ka + 128 + (b_) * 4); } while (0)
#define PV_LOAD(buf, wv, kv) do { _Pragma("unroll") for (int rr = 0; rr < 8; ++rr) { const unsigned key = (unsigned)__builtin_amdgcn_readfirstlane((int)kv[rr >> 2][rr & 3]); \
        buf[rr] = *(const u32x4*)(Vb + (size_t)((PROBE_VF && rep_ == 0) ? (key >> 24) : (key >> 12)) * EROW + 16 * ln); wv[rr] = sus[key & 4095u]; } } while (0)
#define PEER_ACC(buf_, sl_, wgt_) do { const _Float16 wh_ = (_Float16)(wgt_); const h16x2 w2 = (h16x2){wh_, wh_}; _Pragma("unroll") for (int i = 0; i < 4; ++i) { \
        out[sl_][4 * i + 0] = __builtin_elementwise_fma(w2, __builtin_bit_cast(h16x2, __builtin_amdgcn_cvt_scalef32_pk_f16_fp4(buf_[i], 1.0f, 0)), out[sl_][4 * i + 0]); out[sl_][4 * i + 1] = __builtin_elementwise_fma(w2, __builtin_bit_cast(h16x2, __builtin_amdgcn_cvt_scalef32_pk_f16_fp4(buf_[i], 1.0f, 1)), out[sl_][4 * i + 1]); \
        out[sl_][4 * i + 2] = __builtin_elementwise_fma(w2, __builtin_bit_cast(h16x2, __builtin_amdgcn_cvt_scalef32_pk_f16_fp4(buf_[i], 1.0f, 2)), out[sl_][4 * i + 2]); out[sl_][4 * i + 3] = __builtin_elementwise_fma(w2, __builtin_bit_cast(h16x2, __builtin_amdgcn_cvt_scalef32_pk_f16_fp4(buf_[i], 1.0f, 3)), out[sl_][4 * i + 3]); } } while (0)
#define PV_COMP(buf, wv) do { _Pragma("unroll") for (int rr = 0; rr < 8; ++rr) { if (rr < 4) PEER_ACC(buf[rr], 0, wv[rr]); else PEER_ACC(buf[rr], 1, wv[rr]); \
            if (rr < 7) asm volatile("" : "+v"(buf[rr + 1 < 8 ? rr + 1 : 7])); } } while (0)
            if (!(TSKIP & 2)) for (int rep_ = 0; rep_ < (PROBE_V ? 2 : 1); ++rep_) {
                if (PROBE_V && rep_ == 1) {
#pragma unroll
                    for (int sl = 0; sl < 2; ++sl)
#pragma unroll
                        for (int i = 0; i < 16; ++i) { asm volatile("" :: "v"(out[sl][i])); out[sl][i] = (h16x2){(_Float16)0.f, (_Float16)0.f}; }
                }
                u32x4 A[8], B[8], kvA[2], kvB[2]; float wA[8], wB[8];
                PV_KEYS(kvA, 0); PV_KEYS(kvB, 1);
                PV_LOAD(A, wA, kvA); PV_KEYS(kvA, 2);
                for (int b = 0; b < 30; b += 2) {
                    if (align_cnt && (b & 15) == 0) xcd_align(align_cnt + (8 + pr * 4 + (b >> 3)) * 64, nloc, w, lane);
                    PV_LOAD(B, wB, kvB); PV_KEYS(kvB, b + 3); __builtin_amdgcn_sched_barrier(0);
                    PV_COMP(A, wA);
                    PV_LOAD(A, wA, kvA); PV_KEYS(kvA, (b + 4) & 31); __builtin_amdgcn_sched_barrier(0);
                    PV_COMP(B, wB);
                }
                PV_LOAD(B, wB, kvB); __builtin_amdgcn_sched_barrier(0);
                PV_COMP(A, wA); __builtin_amdgcn_sched_barrier(0);
                PV_COMP(B, wB);
            }
#undef PV_KEYS
#undef PV_LOAD
#undef PEER_ACC
#undef PV_COMP
#pragma unroll
            for (int sl = 0; sl < 2; ++sl) {
                const size_t t = (size_t)t0 + w + 8 * (2 * pr + sl);
                float s2 = 0.f; float of[2][16];
#pragma unroll
                for (int j = 0; j < 2; ++j)
#pragma unroll
                    for (int i = 0; i < 4; ++i) { const f32x4 h4 = hres[sl][i + 4 * j];
#pragma unroll
                        for (int c = 0; c < 4; ++c) { const float v_ = (float)out[sl][4 * i + c][j] * (1.0f / 256.0f) + h4[c]; of[j][4 * i + c] = v_; s2 += v_ * v_; } }
                s2 = wave_sum(s2);
                if (layer == DEPTH - 1) {
                    const float r2 = rsqrtf(s2 * (1.0f / DM) + EPS);
#pragma unroll
                    for (int j = 0; j < 2; ++j)
#pragma unroll
                        for (int i = 0; i < 4; ++i) { const int e0 = 256 * (i + 4 * j) + 4 * ln; const f32x4 g4 = *(const f32x4*)(a.final_norm + e0); f32x4 o;
#pragma unroll
                            for (int c = 0; c < 4; ++c) o[c] = of[j][4 * i + c] * r2 * g4[c];
                            *(f32x4*)(outp + t * DM + e0) = o; }
                } else {
#pragma unroll
                    for (int j = 0; j < 2; ++j) {
#pragma unroll
                        for (int i = 0; i < 4; ++i) { const int e0 = 256 * (i + 4 * j) + 4 * ln; f32x4 o;
#pragma unroll
                            for (int c = 0; c < 4; ++c) o[c] = of[j][4 * i + c];
                            *(f32x4*)(Ho + t * DM + e0) = o; }
#pragma unroll
                        for (int i = 0; i < 4; ++i) { const int e0 = 256 * (i + 4 * j) + 4 * ln; u32x2 o;
                            o.x = cvtpk(of[j][4 * i], of[j][4 * i + 1]); o.y = cvtpk(of[j][4 * i + 2], of[j][4 * i + 3]);
                            *(u32x2*)(Hb + t * DM + e0) = o; }
                    }
                    if (ln < 32) ssqo[t * 32 + ln] = ln == 0 ? s2 : 0.f;
                }
            }
        }
    }
}
}

constexpr int CW_BAR = 4096, CW_ALIGN = 32768;
static_assert((CW_ALIGN + DEPTH * 16 * 16 * 64) * 4 <= (int)CTL_ZERO_BYTES, "CTL words inside the memset region");
constexpr int N_PHASES = 2 + 8 * DEPTH;

__global__ void __launch_bounds__(512, 2) mk_fwd(Args args) {
    extern __shared__ __attribute__((aligned(16))) unsigned char lds_raw[];
    Frame F;
    F.lds = (LAS unsigned char*)lds_raw;
    F.tid = threadIdx.x; F.lane = F.tid & 63; F.wave = __builtin_amdgcn_readfirstlane(F.tid >> 6);
    F.G = gridDim.x; { const int bx = blockIdx.x; F.vcu = (F.G % 8 == 0) ? (bx % 8) * (F.G / 8) + bx / 8 : bx; }
    volatile LAS unsigned* MISC = (volatile LAS unsigned*)(F.lds + MISC_OFF);
    if (F.tid < 32) MISC[F.tid] = 0u;
    __syncthreads();
    XcdBarrier bar; bar.bar = (unsigned*)(args.ws + WS_CTL) + CW_BAR; bar.x = 0; bar.st = nullptr;
    if (MK_N_LAUNCHES == 1) bar = xcd_barrier_post((unsigned*)(args.ws + WS_CTL) + CW_BAR, MISC + 8);
    const int lo = args.ph_lo, hi = args.ph_hi;
#ifndef EN_MASK
#define EN_MASK 0xFFFF
#endif
#define EN(b) ((EN_MASK >> (b)) & 1)
#define PROBE(b) ((PROBE_MASK >> (b)) & 1)
#ifndef PROBE_SKIP
#define PROBE_SKIP 0
#endif
#define IN(k) (lo <= (k) && (k) < hi)
#define SEAM(k) do { if ((k) + 1 < hi) xcd_barrier(bar, F.wave); } while (0)

#define PH_BEGIN Frame P = F; { const int l_ = fresh_lane(); P.lane = l_; P.tid = F.wave * 64 + l_; } const __attribute__((address_space(4))) Args* kp_ = (const __attribute__((address_space(4))) Args*)__builtin_amdgcn_kernarg_segment_ptr(); asm volatile("" : "+s"(kp_)); const Args a = *(const Args*)kp_; \
    unsigned char* ws = a.ws; \
    float* H = (float*)(ws + WS_H); bf16_t* Hb = (bf16_t*)(ws + WS_HB); float* ssq = (float*)(ws + WS_SSQ); const LAS float* rs = (const LAS float*)(F.lds + RS_OFF); (void)H; (void)Hb; (void)ssq; (void)rs

    if (EN(0) && IN(0)) { PH_BEGIN; if (PROBE(0)) { p0_prologue(P, a); __syncthreads(); } p0_prologue(P, a); SEAM(0); }
    if (EN(1) && IN(1)) { PH_BEGIN;
        pg8::FoldOrder S{(const char*)(ws + WS_KEYSPAD), (const char*)(ws + WS_WQN), F.G, (int)blockIdx.x};
        pg8::EpiBf16 E{(bf16_t*)(ws + WS_WPT), DM};
        pg8::gemm_phase<256, DM, 256>(F.lds, P.tid, S, E);
    }
    for (int L = 0; L < DEPTH; ++L) {
        const int pb = 2 + 8 * L, j = L >> 1;

        if ((L & 1) == 0) {
            if (EN(2) && IN(pb + 0)) { PH_BEGIN;
                pg8::PlainOrder S; S.init(Hb, DM, (bf16_t*)(ws + WS_WCIN) + (size_t)j * NCIN * DM, DM, T, NCIN, F.G, (int)blockIdx.x);
                fill_rstd(P, S, ssq);
                pg8::EpiConvIn E{(bf16_t*)(ws + WS_BG), (bf16_t*)(ws + WS_Z), rs};
                if (PROBE(2)) { pg8::gemm_phase<DM, DM, DM>(F.lds, P.tid, S, E); __syncthreads(); }
                pg8::gemm_phase<DM, DM, DM>(F.lds, P.tid, S, E);
                SEAM(pb + 0);
            }
            if (EN(3) && IN(pb + 1)) { PH_BEGIN; if (PROBE(3)) { conv_gate_phase(P, (const bf16_t*)(ws + WS_BG), (const bf16_t*)(ws + WS_Z), a.conv_kernel + (size_t)j * 3 * DM, (bf16_t*)(ws + WS_Y)); __syncthreads(); } conv_gate_phase(P, (const bf16_t*)(ws + WS_BG), (const bf16_t*)(ws + WS_Z), a.conv_kernel + (size_t)j * 3 * DM, (bf16_t*)(ws + WS_Y)); SEAM(pb + 1); }
            if (EN(4) && IN(pb + 4)) { PH_BEGIN;
                pg8::PlainOrder S; S.init((bf16_t*)(ws + WS_Y), DM, (bf16_t*)(ws + WS_WCOUT) + (size_t)j * DM * DM, DM, T, DM, F.G, (int)blockIdx.x);
                pg8::EpiResid E{L == 0 ? a.x : (const float*)H, H, Hb, ssq};
                pg8::gemm_phase<DM, DM, DM>(F.lds, P.tid, S, E);
                SEAM(pb + 4);
            }
        } else {
            if (EN(5) && IN(pb + 0)) { PH_BEGIN;
                pg8::PlainOrder S; S.init(Hb, DM, (bf16_t*)(ws + WS_WNIN) + (size_t)j * NNPAD * DM, DM, T, NNPAD, F.G, (int)blockIdx.x);
                fill_rstd(P, S, ssq);
                pg8::EpiNsaIn E{(bf16_t*)(ws + WS_BG), (bf16_t*)(ws + WS_KV), (float*)(ws + WS_GATES), rs};
                if (PROBE(5)) { pg8::gemm_phase<DM, DM, DM>(F.lds, P.tid, S, E); __syncthreads(); }
                const int nbusy = ((T / 256) * (NNPAD / 256)) % F.G, lay = L == 1 ? 2 : 3;
                if (nbusy == 0) convert_expert_rows(a, ws, P.lane, lay * NEXP, lay * NEXP + CONV_SPLIT, (int)blockIdx.x * 8 + F.wave, F.G * 8, 1);
                pg8::gemm_phase<DM, DM, DM>(F.lds, P.tid, S, E);
                if (nbusy != 0 && (int)blockIdx.x >= nbusy) convert_expert_rows(a, ws, P.lane, lay * NEXP, lay * NEXP + CONV_SPLIT, ((int)blockIdx.x - nbusy) * 8 + F.wave, (F.G - nbusy) * 8, 1);
                SEAM(pb + 0);
            }
            if (EN(6) && IN(pb + 1)) { PH_BEGIN;
                pg8::CmpOrder S{(const char*)(ws + WS_KV), (const char*)((bf16_t*)(ws + WS_WC1) + (size_t)j * 2 * 256 * 4096), F.G, (int)blockIdx.x};
                pg8::EpiSlab E{(bf16_t*)(ws + WS_SLAB)};
                if (PROBE(6)) { pg8::gemm_phase<2048, 4096, 512>(F.lds, P.tid, S, E); __syncthreads(); }
                pg8::gemm_phase<2048, 4096, 512>(F.lds, P.tid, S, E);
                { const int lay2 = L == 1 ? 2 : 3;
                  if (F.G > 128) { if ((int)blockIdx.x >= 128) convert_expert_rows(a, ws, P.lane, lay2 * NEXP + CONV_SPLIT, (lay2 + 1) * NEXP, ((int)blockIdx.x - 128) * 8 + F.wave, (F.G - 128) * 8, 1); }
                  else convert_expert_rows(a, ws, P.lane, lay2 * NEXP + CONV_SPLIT, (lay2 + 1) * NEXP, (int)blockIdx.x * 8 + F.wave, F.G * 8, 1); }
                SEAM(pb + 1);
            }
            if (EN(7) && IN(pb + 2)) { PH_BEGIN;
                if (PROBE(7)) { cmp_finalize_phase(P, (const bf16_t*)(ws + WS_SLAB), (const float*)(ws + WS_BIAS1P) + (size_t)j * 2 * 64 * 256, a.cmp_w2_k + (size_t)j * 256 * 128, a.cmp_w2_v + (size_t)j * 256 * 128,
                                   (bf16_t*)(ws + WS_KC), (bf16_t*)(ws + WS_VC)); __syncthreads(); }
                cmp_finalize_phase(P, (const bf16_t*)(ws + WS_SLAB), (const float*)(ws + WS_BIAS1P) + (size_t)j * 2 * 64 * 256, a.cmp_w2_k + (size_t)j * 256 * 128, a.cmp_w2_v + (size_t)j * 256 * 128,
                                   (bf16_t*)(ws + WS_KC), (bf16_t*)(ws + WS_VC));
                SEAM(pb + 2);
            }
            if (EN(8) && IN(pb + 3)) { PH_BEGIN;
                if (PROBE(8)) { att::attn_phase<PROBE_SKIP>(P, (const bf16_t*)(ws + WS_BG), (const bf16_t*)(ws + WS_KV), (const bf16_t*)(ws + WS_KC), (const bf16_t*)(ws + WS_VC), (const float*)(ws + WS_GATES), a.rel_bias, (bf16_t*)(ws + WS_O)); __syncthreads(); }
                att::attn_phase<0>(P, (const bf16_t*)(ws + WS_BG), (const bf16_t*)(ws + WS_KV), (const bf16_t*)(ws + WS_KC), (const bf16_t*)(ws + WS_VC), (const float*)(ws + WS_GATES), a.rel_bias, (bf16_t*)(ws + WS_O));
                SEAM(pb + 3);
            }
            if (EN(9) && IN(pb + 4)) { PH_BEGIN;
                pg8::PlainOrder S; S.init((bf16_t*)(ws + WS_O), DM, (bf16_t*)(ws + WS_WNOUT) + (size_t)j * DM * DM, DM, T, DM, F.G, (int)blockIdx.x);
                pg8::EpiResid E{L == 0 ? a.x : (const float*)H, H, Hb, ssq};
                pg8::gemm_phase<DM, DM, DM>(F.lds, P.tid, S, E);
                SEAM(pb + 4);
            }
        }
        if (EN(10) && IN(pb + 5)) { PH_BEGIN;
            pg8::PlainOrder S; S.init(Hb, DM, (bf16_t*)(ws + WS_WPT) + (size_t)L * DM * DM, DM, T, DM, F.G, (int)blockIdx.x);
            fill_rstd(P, S, ssq);
            pg8::EpiScores E{(bf16_t*)(ws + WS_SC), rs};
            if (PROBE(10)) { pg8::gemm_phase<DM, DM, DM>(F.lds, P.tid, S, E); __syncthreads(); }
            pg8::gemm_phase<DM, DM, DM>(F.lds, P.tid, S, E);
            SEAM(pb + 5);
        }
        if (EN(11) && IN(pb + 6)) { PH_BEGIN;
            if (PROBE(11)) { peer::tail_phase<PROBE_TSKIP>(P, a, L, (const bf16_t*)(ws + WS_SC), H, ssq, (float*)(ws + WS_SLAB), (bf16_t*)(ws + WS_O), (float*)(ws + WS_BG), (float*)(ws + WS_SLAB), ws + WS_UB + (size_t)L * NEXP * EROW, ws + WS_VB + (size_t)L * NEXP * EROW, (const float*)(ws + WS_USC) + (size_t)L * NEXP, (const float*)(ws + WS_VSC) + (size_t)L * NEXP, nullptr, 1u); __syncthreads(); }
            peer::tail_phase<0>(P, a, L, (const bf16_t*)(ws + WS_SC), H, ssq, H, Hb, ssq, a.out, ws + WS_UB + (size_t)L * NEXP * EROW, ws + WS_VB + (size_t)L * NEXP * EROW, (const float*)(ws + WS_USC) + (size_t)L * NEXP, (const float*)(ws + WS_VSC) + (size_t)L * NEXP,
                             MK_N_LAUNCHES == 1 ? (unsigned*)(ws + WS_CTL) + CW_ALIGN + ((L * 16 + (int)xb_xcc_id()) * 16) * 64 : nullptr, MISC[8]);
            SEAM(pb + 6);
        }
    }
#undef IN
#undef EN
#undef SEAM
#undef PH_BEGIN
}

extern "C" void kernel_launch(void* const* d_in, const int* in_sizes, int n_in, void* d_out, int out_size, void* d_ws, size_t ws_size, hipStream_t stream) {
    static int grid = 0;
    if (grid == 0) {
        if (n_in != 20 || out_size != T * DM || ws_size < WS_END) { fprintf(stderr, "kernel_launch: unexpected shapes (n_in %d out %d ws %zu)\n", n_in, out_size, ws_size); grid = -1; return; }
        int dev = 0, cus = 0, per_cu = 0;
        if (hipGetDevice(&dev) != hipSuccess || hipDeviceGetAttribute(&cus, hipDeviceAttributeMultiprocessorCount, dev) != hipSuccess) { grid = -1; return; }
        if (hipFuncSetAttribute((const void*)mk_fwd, hipFuncAttributeMaxDynamicSharedMemorySize, LDS_BYTES) != hipSuccess) { fprintf(stderr, "kernel_launch: hipFuncSetAttribute failed\n"); grid = -1; return; }
        if (hipOccupancyMaxActiveBlocksPerMultiprocessor(&per_cu, (const void*)mk_fwd, 512, LDS_BYTES) != hipSuccess || per_cu < 1) fprintf(stderr, "kernel_launch: occupancy query reports %d\n", per_cu);
        (void)hipGetLastError();
        grid = cus;
    }
    if (grid < 0) return;
    (void)hipMemsetAsync((char*)d_ws + WS_CTL, 0, CTL_ZERO_BYTES, stream);
    Args a{};
    a.x = (const float*)d_in[0]; a.rel_bias = (const float*)d_in[1]; a.mix_norm = (const float*)d_in[2]; a.ffn_norm = (const float*)d_in[3]; a.final_norm = (const float*)d_in[4];
    a.conv_w_in = (const float*)d_in[5]; a.conv_kernel = (const float*)d_in[6]; a.conv_w_out = (const float*)d_in[7];
    a.nsa_w_in = (const float*)d_in[8]; a.cmp_pos_k = (const float*)d_in[9]; a.cmp_pos_v = (const float*)d_in[10]; a.cmp_w1_k = (const float*)d_in[11]; a.cmp_w2_k = (const float*)d_in[12];
    a.cmp_w1_v = (const float*)d_in[13]; a.cmp_w2_v = (const float*)d_in[14]; a.nsa_w_out = (const float*)d_in[15];
    a.peer_w_q = (const float*)d_in[16]; a.peer_sub_keys = (const float*)d_in[17]; a.peer_u = (const float*)d_in[18]; a.peer_v = (const float*)d_in[19];
    a.out = (float*)d_out; a.ws = (unsigned char*)d_ws;
    if (MK_N_LAUNCHES == 1) {
        a.ph_lo = 0; a.ph_hi = N_PHASES; a.li = 0;
        hipLaunchKernelGGL(mk_fwd, dim3(grid), dim3(512), LDS_BYTES, stream, a);
    } else {
        for (int p = 0; p < N_PHASES; ++p) {
            const int s = p < 2 ? -1 : (p - 2) & 7, L = p < 2 ? 0 : (p - 2) >> 3;
            if (s == 7) continue; if ((L & 1) == 0 && (s == 2 || s == 3)) continue;
            a.ph_lo = p; a.ph_hi = p + 1; a.li = p;
            hipLaunchKernelGGL(mk_fwd, dim3(grid), dim3(512), LDS_BYTES, stream, a);
        }
    }
}
```

```cpp
#include <hip/hip_runtime.h>
#include <cstdio>
#include <cstdint>

#ifndef MK_N_LAUNCHES
#define MK_N_LAUNCHES 1
#endif

#ifndef PROBE_MASK
#define PROBE_MASK 0
#endif
#ifndef PROBE_TSKIP
#define PROBE_TSKIP 0
#endif
#ifndef USE_ALIGN
#define USE_ALIGN 0
#endif
#define PROBE_U ((PROBE_MASK >> 14) & 1)
#define PROBE_V ((PROBE_MASK >> 15) & 1)
#define PROBE_UF ((PROBE_MASK >> 16) & 1)
#define PROBE_VF ((PROBE_MASK >> 17) & 1)
#define PROBE_UC ((PROBE_MASK >> 18) & 1)
#define LAS __attribute__((address_space(3)))
#define GAS __attribute__((address_space(1)))
typedef unsigned short bf16_t;
typedef short bf16x8 __attribute__((ext_vector_type(8)));
typedef short s16x4 __attribute__((ext_vector_type(4)));
typedef short v4i16_t __attribute__((ext_vector_type(4)));
typedef float f32x2 __attribute__((ext_vector_type(2)));
typedef _Float16 h16x2 __attribute__((ext_vector_type(2)));
typedef float f32x4 __attribute__((ext_vector_type(4)));
typedef float f32x16 __attribute__((ext_vector_type(16)));
typedef unsigned u32x2 __attribute__((ext_vector_type(2)));
typedef unsigned u32x4 __attribute__((ext_vector_type(4)));
typedef __bf16 bf16x2_t __attribute__((ext_vector_type(2)));
typedef GAS unsigned gu32;

constexpr int DM = 2048, SEQ = 4096, NB = 2, T = NB * SEQ, DEPTH = 4;
constexpr int NCIN = 6144, NNIN = 5168, NNPAD = 5376;
constexpr int NEXP = 16384, EROW = 1024, CONV_SPLIT = 11520  ;
constexpr float EPS = 1e-6f;
constexpr float LOG2E = 1.4426950408889634f;
constexpr float QSCALE = 0.08838834764831845f * LOG2E;

constexpr size_t MiB = 1u << 20;
constexpr size_t WS_CTL = 0, CTL_ZERO_BYTES = 1 * MiB;
constexpr size_t WS_SSQ = 1 * MiB;
constexpr size_t WS_GATES = 2 * MiB;
constexpr size_t WS_BIAS1P = 4 * MiB;
constexpr size_t WS_KC = 5 * MiB;
constexpr size_t WS_VC = 5 * MiB + 512 * 1024;
constexpr size_t WS_KEYSPAD = 6 * MiB;
constexpr size_t WS_WCIN = 16 * MiB;
constexpr size_t WS_WCOUT = 64 * MiB;
constexpr size_t WS_WNIN = 80 * MiB;
constexpr size_t WS_WNOUT = 122 * MiB;
constexpr size_t WS_WQN = 138 * MiB;
constexpr size_t WS_WPT = 170 * MiB;
constexpr size_t WS_WC1 = 202 * MiB;
constexpr size_t WS_H = 256 * MiB;
constexpr size_t WS_HB = 320 * MiB;
constexpr size_t WS_BG = 352 * MiB;
constexpr size_t WS_Z = 384 * MiB;
constexpr size_t WS_Y = 416 * MiB;
constexpr size_t WS_KV = 384 * MiB;
constexpr size_t WS_O = 448 * MiB;
constexpr size_t WS_SC = 480 * MiB;
constexpr size_t WS_SLAB = 544 * MiB;
constexpr size_t WS_UB = 640 * MiB;
constexpr size_t WS_VB = 768 * MiB;
constexpr size_t WS_USC = 896 * MiB;
constexpr size_t WS_VSC = 897 * MiB;
constexpr size_t WS_END = 898 * MiB;

constexpr int RING_BYTES = 155648;
constexpr int RS_OFF = RING_BYTES;
constexpr int MISC_OFF = RS_OFF + 4096;
constexpr int LDS_BYTES = 163840;
static_assert(MISC_OFF + 128 <= LDS_BYTES, "LDS map");

#define LDS_WAIT() asm volatile("s_waitcnt lgkmcnt(0)" ::: "memory")
#define VM_WAIT() asm volatile("s_waitcnt vmcnt(0)" ::: "memory")
#define RLX_AGENT __ATOMIC_RELAXED, __HIP_MEMORY_SCOPE_AGENT

__device__ __forceinline__ unsigned cvtpk(float lo, float hi) { f32x2 v = {lo, hi}; bf16x2_t b = __builtin_convertvector(v, bf16x2_t); return __builtin_bit_cast(unsigned, b); }
__device__ __forceinline__ float bf_lo(unsigned p) { return __uint_as_float(p << 16); }
__device__ __forceinline__ float bf_hi(unsigned p) { return __uint_as_float(p & 0xffff0000u); }
__device__ __forceinline__ float wave_sum(float v) {
#pragma unroll
    for (int o = 1; o < 64; o <<= 1) v += __shfl_xor(v, o);
    return v;
}
template <int CTRL> __device__ __forceinline__ float dpp_f(float x) { return __builtin_bit_cast(float, __builtin_amdgcn_update_dpp(0, __builtin_bit_cast(int, x), CTRL, 0xF, 0xF, true)); }
__device__ __forceinline__ float row_sum16(float x) { x += dpp_f<0xB1>(x); x += dpp_f<0x4E>(x); x += dpp_f<0x141>(x); x += dpp_f<0x140>(x); return x; }
__device__ __forceinline__ float rows_total(float x) {
    const float a = __builtin_bit_cast(float, __builtin_amdgcn_readlane(__builtin_bit_cast(int, x), 0)), b = __builtin_bit_cast(float, __builtin_amdgcn_readlane(__builtin_bit_cast(int, x), 16));
    const float c = __builtin_bit_cast(float, __builtin_amdgcn_readlane(__builtin_bit_cast(int, x), 32)), d = __builtin_bit_cast(float, __builtin_amdgcn_readlane(__builtin_bit_cast(int, x), 48));
    return (a + b) + (c + d);
}
__device__ __forceinline__ float gelu_tanh(float x) {
    const float y = 0.7978845608028654f * (x + 0.044715f * x * x * x);
    const float e = __builtin_amdgcn_exp2f(y * (2.0f * LOG2E));
    const float th = 1.0f - 2.0f * __builtin_amdgcn_rcpf(e + 1.0f);
    return 0.5f * x * (1.0f + th);
}
__device__ __forceinline__ float dot2(unsigned a, unsigned b, float acc) { return __builtin_amdgcn_fdot2_f32_bf16(__builtin_bit_cast(bf16x2_t, a), __builtin_bit_cast(bf16x2_t, b), acc, false); }

__device__ __forceinline__ int fresh_lane() { unsigned z = 0u; asm volatile("v_mov_b32 %0, 0" : "=v"(z)); return (int)__builtin_amdgcn_mbcnt_hi(~0u, __builtin_amdgcn_mbcnt_lo(~0u, z)); }
namespace pg8 {
constexpr int BM = 256, BK = 64, HALF = 128, HTB = HALF * BK * 2, STAGE_BYTES = 8 * HTB, NXCD = 8, WGM = 8;
__host__ __device__ __forceinline__ int lds_byte(int r, int c) { const int st = (r >> 4) * 2 + (c >> 5), rr = r & 15, cc = c & 31, ob = rr * 64 + cc * 2; return st * 1024 + (ob ^ (((ob >> 9) & 1) << 5)); }
__host__ __device__ __forceinline__ void stage_rc(int b, int& R, int& C) { const int st = b / 1024, sb = b % 1024, swz = sb ^ (((sb >> 9) & 1) << 5); R = (st >> 1) * 16 + swz / 64; C = (st & 1) * 32 + (swz % 64) / 2; }
__host__ __device__ __forceinline__ int perm32(int rho) { const int n = rho >> 4, i = rho & 15; return 8 * (i >> 2) + 4 * n + (i & 3); }

struct Unit { int pm, pn, ord; };
struct Gemm { int lda, ldb, K; };

struct PlainOrder {
    const char* A; const char* B; size_t tsA, tsB; int nM, nN, nwg, G, c;
    __device__ void init(const void* A_, int lda, const void* B_, int ldb, int M, int N, int G_, int c_) { A = (const char*)A_; B = (const char*)B_; tsA = (size_t)BM * lda * 2; tsB = (size_t)BM * ldb * 2; nM = M / BM; nN = N / BM; nwg = nM * nN; G = G_; c = c_; }
    __device__ bool next(int i, Unit& u) const {
        const long L = (long)i * G + c; if (L >= nwg) return false;
        int wgid = (int)L; { const int q = nwg / NXCD, r = nwg % NXCD, xcd = wgid % NXCD, off = wgid / NXCD; wgid = (xcd < r ? xcd * (q + 1) : r * (q + 1) + (xcd - r) * q) + off; }
        const int nig = WGM * nN, gid = wgid / nig, fm = gid * WGM, gsz = (nM - fm) < WGM ? (nM - fm) : WGM;
        u.pm = fm + ((wgid % nig) % gsz); u.pn = (wgid % nig) / gsz; u.ord = i; return true;
    }
    __device__ __forceinline__ const char* a_ptr(const Unit& u) const { return A + (size_t)u.pm * tsA; }
    __device__ __forceinline__ const char* b_ptr(const Unit& u) const { return B + (size_t)u.pn * tsB; }
};
struct FoldOrder {
    const char* A; const char* B; int G, c;
    __device__ bool next(int i, Unit& u) const { const int L = i * G + c; if (L >= 256) return false; u.pm = L >> 3; u.pn = L & 7; u.ord = i; return true; }
    __device__ __forceinline__ const char* a_ptr(const Unit& u) const { return A + (size_t)u.pm * 256 * 256 * 2; }
    __device__ __forceinline__ const char* b_ptr(const Unit& u) const { return B + (size_t)(u.pm >> 3) * 2048 * 2048 * 2 + (size_t)u.pn * 256 * 2048 * 2 + (size_t)(u.pm & 7) * 256 * 2; }
};
struct CmpOrder {
    const char* KV; const char* W; int G, c;
    __device__ bool next(int i, Unit& u) const { const int L = i * G + c; if (L >= 128) return false; u.pm = L; u.pn = 0; u.ord = i; return true; }
    __device__ __forceinline__ const char* a_ptr(const Unit& u) const { const int kv = u.pm >> 6, grp = (u.pm >> 3) & 7, ks = u.pm & 7; return KV + ((size_t)(kv * 8 + grp) * 4096 * 128 + (size_t)ks * 512) * 2; }
    __device__ __forceinline__ const char* b_ptr(const Unit& u) const { const int kv = u.pm >> 6, ks = u.pm & 7; return W + ((size_t)kv * 256 * 4096 + (size_t)ks * 512) * 2; }
};

typedef f32x4 Acc[2][2][4][2];

struct EpiConvIn {
    static constexpr bool PERM = true;
    bf16_t* Bg; bf16_t* Z; const LAS float* rs;
    __device__ __forceinline__ void operator()(const Acc& acc, const Unit& u, int wr, int wc, int fr, int fq) const {
#pragma unroll
        for (int ai = 0; ai < 2; ++ai)
#pragma unroll
            for (int m = 0; m < 4; ++m) {
                const int lr = ai * HALF + wr * 64 + m * 16 + fr; const float r = rs[u.ord * 256 + lr]; const size_t grow = (size_t)u.pm * BM + lr;
                if (u.pn < 8) {
#pragma unroll
                    for (int bj = 0; bj < 2; ++bj) { const f32x4 v0 = acc[ai][bj][m][0] * r, v1 = acc[ai][bj][m][1] * r;
                        u32x4 w; w.x = cvtpk(v0[0], v0[1]); w.y = cvtpk(v0[2], v0[3]); w.z = cvtpk(v1[0], v1[1]); w.w = cvtpk(v1[2], v1[3]);
                        *(u32x4*)(Bg + grow * DM + u.pn * 256 + bj * HALF + wc * 32 + 8 * fq) = w; }
                } else {
                    const float r2 = r * r;
                    const f32x4 v0 = acc[ai][0][m][0] * acc[ai][1][m][0] * r2, v1 = acc[ai][0][m][1] * acc[ai][1][m][1] * r2;
                    u32x4 w; w.x = cvtpk(v0[0], v0[1]); w.y = cvtpk(v0[2], v0[3]); w.z = cvtpk(v1[0], v1[1]); w.w = cvtpk(v1[2], v1[3]);
                    *(u32x4*)(Z + grow * DM + (u.pn - 8) * 128 + wc * 32 + 8 * fq) = w;
                }
            }
    }
};
struct EpiResid {
    static constexpr bool PERM = true;
    const float* base32; bf16_t* Hb; float* ssq;
    __device__ __forceinline__ void operator()(const Acc& acc, const Unit& u, int wr, int wc, int fr, int fq) const {
#pragma unroll
        for (int ai = 0; ai < 2; ++ai)
#pragma unroll
            for (int m = 0; m < 4; ++m) {
                const int lr = ai * HALF + wr * 64 + m * 16 + fr; const size_t grow = (size_t)u.pm * BM + lr; const size_t off = grow * DM + u.pn * 256 + wc * 32 + 8 * fq;
                float s = 0.f;
#pragma unroll
                for (int bj = 0; bj < 2; ++bj) { f32x4 b0, b1;
                    if (base32) { b0 = *(const f32x4*)(base32 + off + bj * HALF); b1 = *(const f32x4*)(base32 + off + bj * HALF + 4); }
                    else { const u32x4 hb = *(const u32x4*)(Hb + off + bj * HALF); b0 = (f32x4){bf_lo(hb.x), bf_hi(hb.x), bf_lo(hb.y), bf_hi(hb.y)}; b1 = (f32x4){bf_lo(hb.z), bf_hi(hb.z), bf_lo(hb.w), bf_hi(hb.w)}; }
                    const f32x4 o0 = b0 + acc[ai][bj][m][0], o1 = b1 + acc[ai][bj][m][1];
                    s += ((o0[0] * o0[0] + o0[1] * o0[1]) + (o0[2] * o0[2] + o0[3] * o0[3])) + ((o1[0] * o1[0] + o1[1] * o1[1]) + (o1[2] * o1[2] + o1[3] * o1[3]));
                    u32x4 w; w.x = cvtpk(o0[0], o0[1]); w.y = cvtpk(o0[2], o0[3]); w.z = cvtpk(o1[0], o1[1]); w.w = cvtpk(o1[2], o1[3]);
                    *(u32x4*)(Hb + off + bj * HALF) = w; }
                s += __shfl_xor(s, 16); s += __shfl_xor(s, 32);
                if (fq == 0) ssq[grow * 32 + u.pn * 4 + wc] = s;
            }
    }
};
struct EpiNsaIn {
    static constexpr bool PERM = true;
    bf16_t* Q; bf16_t* KV; float* gates; const LAS float* rs;
    __device__ __forceinline__ void operator()(const Acc& acc, const Unit& u, int wr, int wc, int fr, int fq) const {
#pragma unroll
        for (int ai = 0; ai < 2; ++ai)
#pragma unroll
            for (int m = 0; m < 4; ++m) {
                const int lr = ai * HALF + wr * 64 + m * 16 + fr; const float r = rs[u.ord * 256 + lr]; const size_t grow = (size_t)u.pm * BM + lr;
                if (u.pn < 8) {
                    const float rq = r * QSCALE;
#pragma unroll
                    for (int bj = 0; bj < 2; ++bj) { const f32x4 v0 = acc[ai][bj][m][0] * rq, v1 = acc[ai][bj][m][1] * rq;
                        u32x4 w; w.x = cvtpk(v0[0], v0[1]); w.y = cvtpk(v0[2], v0[3]); w.z = cvtpk(v1[0], v1[1]); w.w = cvtpk(v1[2], v1[3]);
                        *(u32x4*)(Q + grow * DM + u.pn * 256 + bj * HALF + wc * 32 + 8 * fq) = w; }
                } else if (u.pn < 20) {
                    const int nn = (u.pn - 8) >> 1, b = (int)(grow >> 12), s = (int)(grow & 4095);
#pragma unroll
                    for (int bj = 0; bj < 2; ++bj) { const int g = ((u.pn - 8) & 1) * 2 + bj; const f32x4 v0 = acc[ai][bj][m][0] * r, v1 = acc[ai][bj][m][1] * r;
                        u32x4 w; w.x = cvtpk(v0[0], v0[1]); w.y = cvtpk(v0[2], v0[3]); w.z = cvtpk(v1[0], v1[1]); w.w = cvtpk(v1[2], v1[3]);
                        *(u32x4*)(KV + ((size_t)((nn * 2 + b) * 4 + g) * 4096 + s) * 128 + wc * 32 + 8 * fq) = w; }
                } else {
                    const int col = wc * 32 + 8 * fq;
                    if (col < 48) {
                        f32x4 v0 = acc[ai][0][m][0] * r, v1 = acc[ai][0][m][1] * r;
#pragma unroll
                        for (int j = 0; j < 4; ++j) { v0[j] = __builtin_amdgcn_rcpf(1.0f + __builtin_amdgcn_exp2f(-v0[j] * LOG2E)); v1[j] = __builtin_amdgcn_rcpf(1.0f + __builtin_amdgcn_exp2f(-v1[j] * LOG2E)); }
                        *(f32x4*)(gates + grow * 48 + col) = v0; *(f32x4*)(gates + grow * 48 + col + 4) = v1;
                    }
                }
            }
    }
};
struct EpiScores {
    static constexpr bool PERM = true;
    bf16_t* S; const LAS float* rs;
    __device__ __forceinline__ void operator()(const Acc& acc, const Unit& u, int wr, int wc, int fr, int fq) const {
#pragma unroll
        for (int ai = 0; ai < 2; ++ai)
#pragma unroll
            for (int m = 0; m < 4; ++m) {
                const int lr = ai * HALF + wr * 64 + m * 16 + fr; const float r = rs[u.ord * 256 + lr]; bf16_t* rowp = S + ((size_t)u.pm * BM + lr) * DM + u.pn * 256 + wc * 32 + 8 * fq;
#pragma unroll
                for (int bj = 0; bj < 2; ++bj) { const f32x4 v0 = acc[ai][bj][m][0] * r, v1 = acc[ai][bj][m][1] * r;
                    u32x4 w; w.x = cvtpk(v0[0], v0[1]); w.y = cvtpk(v0[2], v0[3]); w.z = cvtpk(v1[0], v1[1]); w.w = cvtpk(v1[2], v1[3]);
                    *(u32x4*)(rowp + bj * HALF) = w; }
            }
    }
};
struct EpiSlab {
    static constexpr bool PERM = true;
    bf16_t* slab;
    __device__ __forceinline__ void operator()(const Acc& acc, const Unit& u, int wr, int wc, int fr, int fq) const {
        const int kv = u.pm >> 6, grp = (u.pm >> 3) & 7, ks = u.pm & 7;
        bf16_t* base = slab + ((size_t)(ks * 2 + kv) * 2048 + grp * 256) * 256;
#pragma unroll
        for (int ai = 0; ai < 2; ++ai)
#pragma unroll
            for (int m = 0; m < 4; ++m) {
                const int lr = ai * HALF + wr * 64 + m * 16 + fr; bf16_t* rowp = base + (size_t)lr * 256 + wc * 32 + 8 * fq;
#pragma unroll
                for (int bj = 0; bj < 2; ++bj) { const f32x4 v0 = acc[ai][bj][m][0], v1 = acc[ai][bj][m][1];
                    u32x4 w; w.x = cvtpk(v0[0], v0[1]); w.y = cvtpk(v0[2], v0[3]); w.z = cvtpk(v1[0], v1[1]); w.w = cvtpk(v1[2], v1[3]);
                    *(u32x4*)(rowp + bj * HALF) = w; }
            }
    }
};
struct EpiBf16 {
    static constexpr bool PERM = true;
    bf16_t* O; int ldc;
    __device__ __forceinline__ void operator()(const Acc& acc, const Unit& u, int wr, int wc, int fr, int fq) const {
#pragma unroll
        for (int ai = 0; ai < 2; ++ai)
#pragma unroll
            for (int m = 0; m < 4; ++m) {
                const int lr = ai * HALF + wr * 64 + m * 16 + fr; bf16_t* rowp = O + ((size_t)u.pm * BM + lr) * ldc + u.pn * 256 + wc * 32 + 8 * fq;
#pragma unroll
                for (int bj = 0; bj < 2; ++bj) { const f32x4 v0 = acc[ai][bj][m][0], v1 = acc[ai][bj][m][1];
                    u32x4 w; w.x = cvtpk(v0[0], v0[1]); w.y = cvtpk(v0[2], v0[3]); w.z = cvtpk(v1[0], v1[1]); w.w = cvtpk(v1[2], v1[3]);
                    *(u32x4*)(rowp + bj * HALF) = w; }
            }
    }
};

template <int LDA, int LDB, int KLEN, class Epi, class Sched>
__device__ __forceinline__ void gemm_phase(LAS unsigned char* lds, int tid, const Sched& S, const Epi& E) {
    constexpr Gemm g{LDA, LDB, KLEN};
    const int wid = __builtin_amdgcn_readfirstlane(tid >> 6), lane = tid & 63, wr = wid >> 2, wc = wid & 3, fr = lane & 15, fq = lane >> 4;
    const int nt = g.K / BK;
    unsigned voffA[2], voffB[2];
#pragma unroll
    for (int i = 0; i < 2; ++i) { int R, C; stage_rc(tid * 16 + i * 8192, R, C); const int Rb = Epi::PERM ? ((R & ~31) + perm32(R & 31)) : R;
        voffA[i] = (unsigned)(R * g.lda + C) * 2u; voffB[i] = (unsigned)(Rb * g.ldb + C) * 2u; }
    const size_t kstep = (size_t)(BK * 2);
    const size_t hstepA = (size_t)HALF * g.lda * 2, hstepB = (size_t)HALF * g.ldb * 2;
    const unsigned ldsw = (unsigned)wid * 1024u;
    const int aoff = lds_byte(wr * 64 + fr, fq * 8), boff = lds_byte(wc * 32 + fr, fq * 8);
#define PG8_SA(b, h) (((b) * 2 + (h)) * HTB)
#define PG8_SB(b, h) ((4 + (b) * 2 + (h)) * HTB)
#define PG8_STAGE(bufoff, gbase, voff) do { _Pragma("unroll") for (int _i = 0; _i < 2; ++_i) \
        __builtin_amdgcn_global_load_lds((const unsigned*)((const char*)(gbase) + (voff)[_i]), (LAS unsigned*)(lds + (bufoff) + ldsw + _i * 8192), 16, 0, 0); } while (0)
#define PG8_LDA(dst, b, h) do { _Pragma("unroll") for (int m = 0; m < 4; ++m) _Pragma("unroll") for (int k = 0; k < 2; ++k) dst[m][k] = *(const LAS bf16x8*)(lds + PG8_SA(b, h) + aoff + m * 2048 + k * 1024); } while (0)
#define PG8_LDB(dst, b, h) do { _Pragma("unroll") for (int n = 0; n < 2; ++n) _Pragma("unroll") for (int k = 0; k < 2; ++k) dst[n][k] = *(const LAS bf16x8*)(lds + PG8_SB(b, h) + boff + n * 2048 + k * 1024); } while (0)
#define PG8_MMA(ai, bj, At, Bt) do { __builtin_amdgcn_s_setprio(1); _Pragma("unroll") for (int m = 0; m < 4; ++m) _Pragma("unroll") for (int n = 0; n < 2; ++n) _Pragma("unroll") for (int k = 0; k < 2; ++k) \
        acc[ai][bj][m][n] = __builtin_amdgcn_mfma_f32_16x16x32_bf16(Bt[n][k], At[m][k], acc[ai][bj][m][n], 0, 0, 0); __builtin_amdgcn_s_setprio(0); } while (0)
#define PG8_WAIT_V(n) asm volatile("s_waitcnt vmcnt(" #n ")" ::: "memory")
#define PG8_WAIT_L(n) asm volatile("s_waitcnt lgkmcnt(" #n ")" ::: "memory")
#define PG8_BAR __builtin_amdgcn_s_barrier()
#define PG8_SCHED __builtin_amdgcn_sched_barrier(0)
    Unit cur, nxt; int ui = 0;
    if (!S.next(0, cur)) return;
    Acc acc;
#pragma unroll
    for (int a = 0; a < 2; ++a)
#pragma unroll
        for (int b = 0; b < 2; ++b)
#pragma unroll
            for (int m = 0; m < 4; ++m)
#pragma unroll
                for (int n = 0; n < 2; ++n) acc[a][b][m][n] = (f32x4){0.f, 0.f, 0.f, 0.f};
    bf16x8 At[4][2], B0[2][2], B1[2][2];
    const char* cA = S.a_ptr(cur); const char* cB = S.b_ptr(cur);
    asm volatile("" : "+s"(cA), "+s"(cB));
    PG8_STAGE(PG8_SB(0, 0), cB, voffB); PG8_STAGE(PG8_SB(0, 1), cB + hstepB, voffB); PG8_STAGE(PG8_SA(0, 0), cA, voffA); PG8_STAGE(PG8_SA(0, 1), cA + hstepA, voffA);
    if (wr == 1) PG8_BAR;
    PG8_WAIT_V(2); PG8_BAR;
    PG8_STAGE(PG8_SB(1, 0), cB + kstep, voffB); PG8_STAGE(PG8_SA(1, 0), cA + kstep, voffA); PG8_STAGE(PG8_SB(1, 1), cB + hstepB + kstep, voffB);
    PG8_WAIT_V(6); PG8_BAR;
    for (;;) {
        const bool has_next = S.next(ui + 1, nxt);
        const char* nA = has_next ? S.a_ptr(nxt) : cA; const char* nB = has_next ? S.b_ptr(nxt) : cB;
        asm volatile("" : "+s"(nA), "+s"(nB));
        for (int t = 0; t < nt; t += 2) {
            const bool last = (t == nt - 2);
            const char* a1 = cA + (size_t)(t + 1) * kstep;
            const char* a2 = last ? nA : cA + (size_t)(t + 2) * kstep; const char* b2 = last ? nB : cB + (size_t)(t + 2) * kstep;
            const char* a3 = a2 + kstep; const char* b3 = b2 + kstep;
            asm volatile("" : "+s"(a1), "+s"(a2), "+s"(b2), "+s"(a3), "+s"(b3));
            PG8_LDB(B0, 0, 0); PG8_LDB(B1, 0, 1); PG8_SCHED; PG8_LDA(At, 0, 0); PG8_STAGE(PG8_SA(1, 1), a1 + hstepA, voffA);
            PG8_WAIT_V(8); PG8_WAIT_L(0); PG8_BAR; PG8_MMA(0, 0, At, B0); PG8_MMA(0, 1, At, B1); PG8_BAR; PG8_SCHED;
            PG8_LDA(At, 0, 1); PG8_STAGE(PG8_SB(0, 0), b2, voffB); PG8_STAGE(PG8_SB(0, 1), b2 + hstepB, voffB); PG8_STAGE(PG8_SA(0, 0), a2, voffA);
            PG8_WAIT_V(8); PG8_WAIT_L(0); PG8_BAR; PG8_MMA(1, 0, At, B0); PG8_MMA(1, 1, At, B1); PG8_BAR; PG8_SCHED;
            PG8_LDB(B0, 1, 0); PG8_LDB(B1, 1, 1); PG8_SCHED; PG8_LDA(At, 1, 0); PG8_STAGE(PG8_SA(0, 1), a2 + hstepA, voffA);
            PG8_WAIT_V(8); PG8_WAIT_L(0); PG8_BAR; PG8_MMA(0, 0, At, B0); PG8_MMA(0, 1, At, B1); PG8_BAR; PG8_SCHED;
            PG8_LDA(At, 1, 1); PG8_STAGE(PG8_SB(1, 0), b3, voffB); PG8_STAGE(PG8_SB(1, 1), b3 + hstepB, voffB); PG8_STAGE(PG8_SA(1, 0), a3, voffA);
            PG8_WAIT_V(8); PG8_WAIT_L(0); PG8_BAR; PG8_MMA(1, 0, At, B0); PG8_MMA(1, 1, At, B1); PG8_BAR; PG8_SCHED;
        }
        if (wr == 0) PG8_BAR;
        { const int l_e = fresh_lane();
          E(acc, cur, wr, wc, l_e & 15, l_e >> 4); }
        if (!has_next) break;
#pragma unroll
        for (int a = 0; a < 2; ++a)
#pragma unroll
            for (int b = 0; b < 2; ++b)
#pragma unroll
                for (int m = 0; m < 4; ++m)
#pragma unroll
                    for (int n = 0; n < 2; ++n) acc[a][b][m][n] = (f32x4){0.f, 0.f, 0.f, 0.f};
        cur = nxt; cA = nA; cB = nB; ++ui;
        if (wr == 1) PG8_BAR;
    }
    PG8_WAIT_V(0);
    PG8_BAR;
#undef PG8_SA
#undef PG8_SB
#undef PG8_STAGE
#undef PG8_LDA
#undef PG8_LDB
#undef PG8_MMA
#undef PG8_WAIT_V
#undef PG8_WAIT_L
#undef PG8_BAR
#undef PG8_SCHED
}
}

#define XB_TMO      128
#define XB_XCNT(j)  (256  + 64 * (j))
#define XB_XSUB(j)  (1280 + 64 * (j))
#define XB_XGEN(j)  (2304 + 64 * (j))
#define XB_TOP      3328
#define XB_TOPGEN   3392
#define XCD_BAR_WORDS 3456
#define XB_SPIN_CAP (1u << 22)
__device__ __forceinline__ unsigned xb_ld(unsigned* p)              { return __hip_atomic_load(p, __ATOMIC_RELAXED, __HIP_MEMORY_SCOPE_AGENT); }
__device__ __forceinline__ unsigned xb_add(unsigned* p, unsigned v) { return __hip_atomic_fetch_add(p, v, __ATOMIC_RELAXED, __HIP_MEMORY_SCOPE_AGENT); }
__device__ __forceinline__ unsigned xb_xcc_id() { return (unsigned)__builtin_amdgcn_s_getreg((3 << 11) | 20) & 0xFu; }
#define XB_SPIN(cond, bar) do { unsigned _sp = 0; while (cond) { __builtin_amdgcn_s_sleep(1); \
    if ((++_sp & 255u) == 0u) { if (xb_ld(&(bar)[XB_TMO])) break; if (_sp > XB_SPIN_CAP) { atomicAdd(&(bar)[XB_TMO], 1u); break; } } } } while (0)
struct XcdBarrier { unsigned* bar; unsigned x; volatile LAS unsigned* st; };
__device__ __forceinline__ XcdBarrier xcd_barrier_post(unsigned* bar, volatile LAS unsigned* st) {
    XcdBarrier b; b.bar = bar; b.x = xb_xcc_id(); b.st = st;
    if (threadIdx.x == 0) (void)xb_add(&bar[XB_XCNT(b.x)], 1u);
    return b;
}
__device__ __forceinline__ void xcd_barrier_complete(unsigned* bar, unsigned x, unsigned& nloc, unsigned& nx) {
    const unsigned G = gridDim.x * gridDim.y * gridDim.z;
    unsigned sum, cnt, mine, sp = 0u;
    for (;;) {
        sum = 0u; cnt = 0u; mine = 0u;
#pragma unroll
        for (unsigned j = 0; j < 16; ++j) { const unsigned c = xb_ld(&bar[XB_XCNT(j)]); sum += c; cnt += (c > 0u) ? 1u : 0u; }
        mine = xb_ld(&bar[XB_XCNT(x)]);
        if (sum == G) break;
        __builtin_amdgcn_s_sleep(1);
        if ((++sp & 255u) == 0u) { if (xb_ld(&bar[XB_TMO])) break; if (sp > XB_SPIN_CAP) { atomicAdd(&bar[XB_TMO], 1u); break; } }
    }
    nloc = mine > 0u ? mine : 1u; nx = cnt > 0u ? cnt : 1u;
}
__device__ __forceinline__ void xcd_barrier(const XcdBarrier& b, int wave) {
    asm volatile("s_waitcnt vmcnt(0)" ::: "memory");
    __syncthreads();
    if (wave == 0 && fresh_lane() == 0) {
        unsigned* bar = b.bar; asm volatile("" : "+s"(bar));
        __builtin_amdgcn_s_waitcnt(0);
        unsigned nloc = b.st[0], nx = b.st[1];
        if (nloc == 0u) { xcd_barrier_complete(bar, b.x, nloc, nx); b.st[0] = nloc; b.st[1] = nx; }
        const unsigned old = xb_add(&bar[XB_XSUB(b.x)], 1u);
        const unsigned gen = old / nloc;
        if (old + 1u == (gen + 1u) * nloc) {
            __builtin_amdgcn_fence(__ATOMIC_RELEASE, "agent");
            asm volatile("s_waitcnt vmcnt(0)" ::: "memory");
            const unsigned og = xb_add(&bar[XB_TOP], 1u);
            const unsigned tg = og / nx;
            if (og + 1u == (tg + 1u) * nx) xb_add(&bar[XB_TOPGEN], 1u);
            else XB_SPIN(xb_ld(&bar[XB_TOPGEN]) == tg, bar);
            __builtin_amdgcn_fence(__ATOMIC_ACQUIRE, "agent");
            xb_add(&bar[XB_XGEN(b.x)], 1u);
            asm volatile("s_waitcnt vmcnt(0)" ::: "memory");
        } else {
            XB_SPIN(xb_ld(&bar[XB_XGEN(b.x)]) == gen, bar);
            __builtin_amdgcn_fence(__ATOMIC_ACQUIRE, "agent");
            asm volatile("s_waitcnt vmcnt(0)" ::: "memory");
        }
    }
    __syncthreads();
}

struct Args {
    const float* x; const float* rel_bias; const float* mix_norm; const float* ffn_norm; const float* final_norm;
    const float* conv_w_in; const float* conv_kernel; const float* conv_w_out;
    const float* nsa_w_in; const float* cmp_pos_k; const float* cmp_pos_v; const float* cmp_w1_k; const float* cmp_w2_k; const float* cmp_w1_v; const float* cmp_w2_v; const float* nsa_w_out;
    const float* peer_w_q; const float* peer_sub_keys; const float* peer_u; const float* peer_v;
    float* out; unsigned char* ws; int ph_lo, ph_hi, li, pad;
};
struct Frame { LAS unsigned char* lds; int tid, lane, wave, vcu, G; };

struct TrItem { const float* W; const float* gain; bf16_t* WT; int K, Nsrc, k0, n0, sn0; };
__device__ __forceinline__ void tr_load(const TrItem& t, f32x4 (&tv)[8], int lane) {
#pragma unroll
    for (int i = 0; i < 8; ++i) { const int kk = 8 * i + (lane >> 3), col = 4 * (lane & 7); const float* p = t.W + (size_t)(t.k0 + kk) * t.Nsrc + t.sn0 + col;
        if (t.sn0 + col + 3 < t.Nsrc) tv[i] = *(const f32x4*)p;
        else { tv[i][0] = t.sn0 + col < t.Nsrc ? p[0] : 0.f; tv[i][1] = t.sn0 + col + 1 < t.Nsrc ? p[1] : 0.f; tv[i][2] = t.sn0 + col + 2 < t.Nsrc ? p[2] : 0.f; tv[i][3] = 0.f; } }
}
__device__ __forceinline__ void tr_finish(const TrItem& t, const f32x4 (&tv)[8], LAS float* scr, int lane) {
#pragma unroll
    for (int i = 0; i < 8; ++i) { const int kk = 8 * i + (lane >> 3), col = 4 * (lane & 7); const float gk = t.gain ? t.gain[t.k0 + kk] : 1.0f;
        scr[kk * 33 + col] = tv[i][0] * gk; scr[kk * 33 + col + 1] = tv[i][1] * gk; scr[kk * 33 + col + 2] = tv[i][2] * gk; scr[kk * 33 + col + 3] = tv[i][3] * gk; }
    LDS_WAIT(); asm volatile("" ::: "memory");
    const int c = lane & 7;
#pragma unroll
    for (int j = 0; j < 4; ++j) { const int n = (lane >> 3) + 8 * j; const LAS float* s = scr + (8 * c) * 33 + n;
        u32x4 o; o.x = cvtpk(s[0 * 33], s[1 * 33]); o.y = cvtpk(s[2 * 33], s[3 * 33]); o.z = cvtpk(s[4 * 33], s[5 * 33]); o.w = cvtpk(s[6 * 33], s[7 * 33]);
        *(u32x4*)(t.WT + (size_t)(t.n0 + n) * t.K + t.k0 + 8 * c) = o; }
    LDS_WAIT(); asm volatile("" ::: "memory");
}
__device__ __forceinline__ void tr_set(TrItem& t, const float* W, int K, int Nsrc, int Ndst, const float* gain, bf16_t* WT, int item, int mode) {
    const int nblk = Ndst / 32, kb = item / nblk, nb = item % nblk; t.W = W; t.gain = gain; t.WT = WT; t.K = K; t.Nsrc = Nsrc; t.k0 = 64 * kb; t.n0 = 32 * nb; t.sn0 = t.n0;
    if (mode == 1 && t.n0 >= 2048) { const int r = t.n0 - 2048, kk = r >> 8, xx = r & 255; t.sn0 = xx < 128 ? 2048 + 128 * kk + xx : 4096 + 128 * kk + (xx - 128); }
}

__device__ __forceinline__ void convert_expert_rows(const Args& a, unsigned char* ws, int lane, int row_lo, int row_hi, int rw, int nw, int reps) {
    for (int tb = 0; tb < 2 * reps; ++tb) {
        const float* src = (tb & 1) ? a.peer_v : a.peer_u; unsigned char* dst = ws + ((tb & 1) ? WS_VB : WS_UB); float* scl = (float*)(ws + ((tb & 1) ? WS_VSC : WS_USC));
#define EXP_LOAD(v_, row_) do { const float* sr = src + (size_t)(row_) * DM + 4 * lane; _Pragma("unroll") for (int j = 0; j < 2; ++j) _Pragma("unroll") for (int i = 0; i < 4; ++i) v_[j][i] = __builtin_nontemporal_load((const f32x4*)(sr + 256 * (i + 4 * j))); } while (0)
#define EXP_DONE(v_, row_) do { float ss = 0.f; \
            _Pragma("unroll") for (int j = 0; j < 2; ++j) _Pragma("unroll") for (int i = 0; i < 4; ++i) ss += (v_[j][i][0] * v_[j][i][0] + v_[j][i][1] * v_[j][i][1]) + (v_[j][i][2] * v_[j][i][2] + v_[j][i][3] * v_[j][i][3]); \
            ss = rows_total(row_sum16(ss)); \
            const float rms = __builtin_sqrtf(ss * (1.0f / DM)); u32x4 o; \
            if (tb & 1) { const float sc = rms > 0.f ? 2.0f / rms : 1.0f; \
                _Pragma("unroll") for (int i = 0; i < 4; ++i) { unsigned w_ = 0u; \
                    w_ = __builtin_amdgcn_cvt_scalef32_pk_fp4_f32(w_, v_[0][i][0] * sc, v_[1][i][0] * sc, 1.0f, 0); w_ = __builtin_amdgcn_cvt_scalef32_pk_fp4_f32(w_, v_[0][i][1] * sc, v_[1][i][1] * sc, 1.0f, 1); \
                    w_ = __builtin_amdgcn_cvt_scalef32_pk_fp4_f32(w_, v_[0][i][2] * sc, v_[1][i][2] * sc, 1.0f, 2); w_ = __builtin_amdgcn_cvt_scalef32_pk_fp4_f32(w_, v_[0][i][3] * sc, v_[1][i][3] * sc, 1.0f, 3); o[i] = w_; } \
                if (lane == 0) scl[row_] = rms > 0.f ? rms * 0.5f : 1.0f; \
            } else { const float step = 0.3352f * rms, sc = rms > 0.f ? 1.0f / step : 0.f; \
                _Pragma("unroll") for (int i = 0; i < 4; ++i) { unsigned w_ = 0u; \
                    _Pragma("unroll") for (int c = 0; c < 4; ++c) { const int q0 = (int)__builtin_fminf(__builtin_fmaxf(__builtin_floorf(v_[0][i][c] * sc), -8.0f), 7.0f), q1 = (int)__builtin_fminf(__builtin_fmaxf(__builtin_floorf(v_[1][i][c] * sc), -8.0f), 7.0f); \
                        w_ |= (((unsigned)q0 & 15u) | (((unsigned)q1 & 15u) << 4)) << (8 * c); } \
                    o[i] = w_; } \
                if (lane == 0) scl[row_] = step; } \
            *(u32x4*)(dst + (size_t)(row_) * EROW + 16 * lane) = o; } while (0)
        {
            f32x4 va[2][4], vb[2][4];
            int row = row_lo + rw;
            if (row < row_hi) EXP_LOAD(va, row);
            for (; row < row_hi; row += 2 * nw) {
                const int r1 = row + nw, r2 = row + 2 * nw;
                if (r1 < row_hi) EXP_LOAD(vb, r1);
                __builtin_amdgcn_sched_barrier(0);
                EXP_DONE(va, row);
                if (r2 < row_hi) EXP_LOAD(va, r2);
                __builtin_amdgcn_sched_barrier(0);
                if (r1 < row_hi) EXP_DONE(vb, r1);
            }
        }
#undef EXP_LOAD
#undef EXP_DONE
    }
}

__device__ __forceinline__ void p0_prologue(const Frame& F, const Args& a) {
    unsigned char* ws = a.ws;
    LAS float* scr = (LAS float*)(F.lds + F.wave * 16384);
    const int gw = F.vcu * 8 + F.wave, NGW = F.G * 8;
    for (int it = gw; it < 256; it += NGW) {
        const int chunk = it & 63, kv = (it >> 6) & 1, j = it >> 7;
        const float* pos = (kv ? a.cmp_pos_v : a.cmp_pos_k) + (size_t)j * 4096; const float* w1 = (kv ? a.cmp_w1_v : a.cmp_w1_k) + (size_t)j * 4096 * 256;
        f32x4 acc[8];
#pragma unroll
        for (int u = 0; u < 8; ++u) acc[u] = (f32x4){0.f, 0.f, 0.f, 0.f};
        for (int k = chunk * 64; k < chunk * 64 + 64; k += 8) {
#pragma unroll
            for (int u = 0; u < 8; ++u) acc[u] += *(const f32x4*)(w1 + (size_t)(k + u) * 256 + 4 * F.lane) * pos[k + u]; }
        *(f32x4*)((float*)(ws + WS_BIAS1P) + (size_t)it * 256 + 4 * F.lane) = ((acc[0] + acc[1]) + (acc[2] + acc[3])) + ((acc[4] + acc[5]) + (acc[6] + acc[7]));
    }
    constexpr int I_CIN = 32 * (NCIN / 32), I_SQ = 32 * (DM / 32), I_NIN = 32 * (NNPAD / 32), I_C1 = 64 * (256 / 32);
    constexpr int NIT = 2 * I_CIN + 2 * I_SQ + 2 * I_NIN + 2 * I_SQ + 4 * I_C1;
#define TR_DECODE(t_, it_) do { int r = (it_); \
        if (r < 2 * I_CIN) { const int j = r / I_CIN; r -= j * I_CIN; tr_set(t_, a.conv_w_in + (size_t)j * DM * NCIN, DM, NCIN, NCIN, a.mix_norm + (size_t)(2 * j) * DM, (bf16_t*)(ws + WS_WCIN) + (size_t)j * NCIN * DM, r, 1); break; } r -= 2 * I_CIN; \
        if (r < 2 * I_SQ) { const int j = r / I_SQ; r -= j * I_SQ; tr_set(t_, a.conv_w_out + (size_t)j * DM * DM, DM, DM, DM, nullptr, (bf16_t*)(ws + WS_WCOUT) + (size_t)j * DM * DM, r, 0); break; } r -= 2 * I_SQ; \
        if (r < 2 * I_NIN) { const int j = r / I_NIN; r -= j * I_NIN; tr_set(t_, a.nsa_w_in + (size_t)j * DM * NNIN, DM, NNIN, NNPAD, a.mix_norm + (size_t)(2 * j + 1) * DM, (bf16_t*)(ws + WS_WNIN) + (size_t)j * NNPAD * DM, r, 2); break; } r -= 2 * I_NIN; \
        if (r < 2 * I_SQ) { const int j = r / I_SQ; r -= j * I_SQ; tr_set(t_, a.nsa_w_out + (size_t)j * DM * DM, DM, DM, DM, nullptr, (bf16_t*)(ws + WS_WNOUT) + (size_t)j * DM * DM, r, 0); break; } r -= 2 * I_SQ; \
        { const int q = r / I_C1; r -= q * I_C1; const int j = q >> 1, kv = q & 1; tr_set(t_, (kv ? a.cmp_w1_v : a.cmp_w1_k) + (size_t)j * 4096 * 256, 4096, 256, 256, nullptr, (bf16_t*)(ws + WS_WC1) + (size_t)q * 256 * 4096, r, 0); } } while (0)
    for (int rep = 0; rep < (((PROBE_MASK >> 13) & 1) ? 2 : 1); ++rep) {
        TrItem ta, tb; f32x4 va[8], vb[8];
        int it = gw;
        if (it < NIT) { TR_DECODE(ta, it); tr_load(ta, va, F.lane); }
        for (; it < NIT; it += 2 * NGW) {
            const int i1 = it + NGW, i2 = it + 2 * NGW;
            if (i1 < NIT) { TR_DECODE(tb, i1); tr_load(tb, vb, F.lane); }
            __builtin_amdgcn_sched_barrier(0);
            tr_finish(ta, va, scr, F.lane);
            if (i2 < NIT) { TR_DECODE(ta, i2); tr_load(ta, va, F.lane); }
            __builtin_amdgcn_sched_barrier(0);
            if (i1 < NIT) tr_finish(tb, vb, scr, F.lane);
        }
    }
#undef TR_DECODE
    const size_t gt = (size_t)F.vcu * 512 + F.tid, NGT = (size_t)F.G * 512;
    for (size_t ch = gt; ch < (size_t)DEPTH * DM * DM / 8; ch += 2 * NGT) {
        f32x4 v[2][2]; float gk[2];
#pragma unroll
        for (int q = 0; q < 2; ++q) { const size_t e = (ch + q * NGT) * 8; const int i = (int)(e / ((size_t)DM * DM)), k = (int)((e / DM) % DM); gk[q] = a.ffn_norm[i * DM + k];
            v[q][0] = *(const f32x4*)(a.peer_w_q + e); v[q][1] = *(const f32x4*)(a.peer_w_q + e + 4); }
#pragma unroll
        for (int q = 0; q < 2; ++q) { const size_t e = (ch + q * NGT) * 8; const f32x4 v0 = v[q][0] * gk[q], v1 = v[q][1] * gk[q];
            u32x4 o; o.x = cvtpk(v0[0], v0[1]); o.y = cvtpk(v0[2], v0[3]); o.z = cvtpk(v1[0], v1[1]); o.w = cvtpk(v1[2], v1[3]);
            *(u32x4*)((bf16_t*)(ws + WS_WQN) + e) = o; }
    }
    for (size_t ch = gt; ch < (size_t)DEPTH * 2048 * 256 / 8; ch += NGT) {
        const size_t e = ch * 8; const int col = (int)(e & 255), row = (int)((e >> 8) & 2047), i = (int)(e >> 19);
        const int p = (row >> 7) & 1; u32x4 o = (u32x4){0u, 0u, 0u, 0u};
        if ((col >> 7) == p) { const float* src = a.peer_sub_keys + ((size_t)i * 2048 + row) * 128 + (col & 127);
            const f32x4 v0 = *(const f32x4*)src, v1 = *(const f32x4*)(src + 4);
            o.x = cvtpk(v0[0], v0[1]); o.y = cvtpk(v0[2], v0[3]); o.z = cvtpk(v1[0], v1[1]); o.w = cvtpk(v1[2], v1[3]); }
        *(u32x4*)((bf16_t*)(ws + WS_KEYSPAD) + e) = o;
    }
    convert_expert_rows(a, ws, F.lane, 0, 2 * NEXP, gw, NGW, ((PROBE_MASK >> 12) & 1) ? 2 : 1);
    for (int m = gw; m < T; m += NGW) {
        const float* xr = a.x + (size_t)m * DM; bf16_t* hb = (bf16_t*)(ws + WS_HB) + (size_t)m * DM; float s = 0.f;
#pragma unroll
        for (int j = 0; j < 4; ++j) { const int e0 = 512 * j + 8 * F.lane; const f32x4 v0 = *(const f32x4*)(xr + e0), v1 = *(const f32x4*)(xr + e0 + 4);
            s += (v0[0] * v0[0] + v0[1] * v0[1]) + (v0[2] * v0[2] + v0[3] * v0[3]) + (v1[0] * v1[0] + v1[1] * v1[1]) + (v1[2] * v1[2] + v1[3] * v1[3]);
            u32x4 o; o.x = cvtpk(v0[0], v0[1]); o.y = cvtpk(v0[2], v0[3]); o.z = cvtpk(v1[0], v1[1]); o.w = cvtpk(v1[2], v1[3]); *(u32x4*)(hb + e0) = o; }
        s = wave_sum(s);
        if (F.lane < 32) ((float*)(ws + WS_SSQ))[(size_t)m * 32 + F.lane] = F.lane == 0 ? s : 0.f;
    }
}

template <class Sched>
__device__ __forceinline__ void fill_rstd(const Frame& F, const Sched& S, const float* ssq) {
    LAS float* rs = (LAS float*)(F.lds + RS_OFF);
    pg8::Unit u;
    for (int i = 0; S.next(i, u); ++i) {
        if (F.tid < 256) { const f32x4* p = (const f32x4*)(ssq + ((size_t)u.pm * 256 + F.tid) * 32); float s = 0.f;
#pragma unroll
            for (int k = 0; k < 8; ++k) { const f32x4 v = p[k]; s += (v[0] + v[1]) + (v[2] + v[3]); }
            rs[i * 256 + F.tid] = rsqrtf(s * (1.0f / DM) + EPS); }
    }
    __syncthreads();
}

__device__ __forceinline__ void conv_gate_phase(const Frame& F, const bf16_t* Bg, const bf16_t* Z, const float* ck, bf16_t* Y) {
    const int gt = F.vcu * 512 + F.tid, NGT = F.G * 512;
    for (int it = gt; it < (T / 16) * 256; it += NGT) {
        const int c8 = (it & 255) * 8, r0 = (it >> 8) * 16, s0 = r0 & (SEQ - 1);
        float k0[8], k1[8], k2[8];
        *(f32x4*)k0 = *(const f32x4*)(ck + c8); *(f32x4*)(k0 + 4) = *(const f32x4*)(ck + c8 + 4);
        *(f32x4*)k1 = *(const f32x4*)(ck + DM + c8); *(f32x4*)(k1 + 4) = *(const f32x4*)(ck + DM + c8 + 4);
        *(f32x4*)k2 = *(const f32x4*)(ck + 2 * DM + c8); *(f32x4*)(k2 + 4) = *(const f32x4*)(ck + 2 * DM + c8 + 4);
        u32x4 z1 = (u32x4){0u, 0u, 0u, 0u}, z2 = z1;
        if (s0 >= 1) z1 = *(const u32x4*)(Z + (size_t)(r0 - 1) * DM + c8);
        if (s0 >= 2) z2 = *(const u32x4*)(Z + (size_t)(r0 - 2) * DM + c8);
#pragma unroll
        for (int h = 0; h < 2; ++h) {
            u32x4 zz[8], bb[8];
#pragma unroll
            for (int i = 0; i < 8; ++i) { zz[i] = *(const u32x4*)(Z + (size_t)(r0 + 8 * h + i) * DM + c8); bb[i] = *(const u32x4*)(Bg + (size_t)(r0 + 8 * h + i) * DM + c8); }
#pragma unroll
            for (int i = 0; i < 8; ++i) {
                const u32x4 z0 = zz[i], bg = bb[i]; u32x4 o;
#pragma unroll
                for (int j = 0; j < 4; ++j) {
                    const float lo = bf_lo(bg[j]) * (k0[2 * j] * bf_lo(z2[j]) + k1[2 * j] * bf_lo(z1[j]) + k2[2 * j] * bf_lo(z0[j]));
                    const float hi = bf_hi(bg[j]) * (k0[2 * j + 1] * bf_hi(z2[j]) + k1[2 * j + 1] * bf_hi(z1[j]) + k2[2 * j + 1] * bf_hi(z0[j]));
                    o[j] = cvtpk(lo, hi);
                }
                *(u32x4*)(Y + (size_t)(r0 + 8 * h + i) * DM + c8) = o;
                z2 = z1; z1 = z0;
            }
        }
    }
}

__device__ __forceinline__ void cmp_finalize_phase(const Frame& F, const bf16_t* slab, const float* bias1p  , const float* w2k, const float* w2v, bf16_t* KC, bf16_t* VC) {
    LAS float* bpart = (LAS float*)(F.lds);
    LAS unsigned char* hid = F.lds + 8192;
    const int w = F.wave;
    for (int it = F.vcu; it < 256; it += F.G) {
        int ln = F.lane; asm volatile("" : "+v"(ln));
        const int kv = it >> 7, row0 = (it & 127) * 16;
        __syncthreads();
        u32x2 hv[2][8];
#pragma unroll
        for (int rr = 0; rr < 2; ++rr)
#pragma unroll
            for (int ks = 0; ks < 8; ++ks) hv[rr][ks] = *(const u32x2*)(slab + ((size_t)(ks * 2 + kv) * 2048 + row0 + 2 * w + rr) * 256 + 4 * ln);
        { f32x4 bs = (f32x4){0.f, 0.f, 0.f, 0.f};
#pragma unroll
          for (int c = 0; c < 8; ++c) bs += *(const f32x4*)(bias1p + ((size_t)kv * 64 + 8 * w + c) * 256 + 4 * ln);
          *(LAS f32x4*)(bpart + w * 256 + 4 * ln) = bs; }
        const float* w2 = (kv ? w2v : w2k) + 16 * w + (ln & 15) + (size_t)(8 * (ln >> 4)) * 128;
        float wf[8][8];
#pragma unroll
        for (int s_ = 0; s_ < 8; ++s_)
#pragma unroll
            for (int j = 0; j < 8; ++j) wf[s_][j] = w2[(size_t)(32 * s_ + j) * 128];
        __syncthreads();
        f32x4 bias = (f32x4){0.f, 0.f, 0.f, 0.f};
#pragma unroll
        for (int c = 0; c < 8; ++c) bias += *(const LAS f32x4*)(bpart + c * 256 + 4 * ln);
#pragma unroll
        for (int rr = 0; rr < 2; ++rr) {
            f32x4 h = bias;
#pragma unroll
            for (int ks = 0; ks < 8; ++ks) { h[0] += bf_lo(hv[rr][ks].x); h[1] += bf_hi(hv[rr][ks].x); h[2] += bf_lo(hv[rr][ks].y); h[3] += bf_hi(hv[rr][ks].y); }
            u32x2 o; o.x = cvtpk(gelu_tanh(h[0]), gelu_tanh(h[1])); o.y = cvtpk(gelu_tanh(h[2]), gelu_tanh(h[3]));
            *(LAS u32x2*)(hid + (2 * w + rr) * 528 + 8 * ln) = o;
        }
        __syncthreads();
        f32x4 acc = (f32x4){0.f, 0.f, 0.f, 0.f};
        const int fr = ln & 15, fq = ln >> 4;
#pragma unroll
        for (int s_ = 0; s_ < 8; ++s_) {
            const bf16x8 hf = *(const LAS bf16x8*)(hid + fr * 528 + 64 * s_ + 16 * fq);
            u32x4 wp; wp.x = cvtpk(wf[s_][0], wf[s_][1]); wp.y = cvtpk(wf[s_][2], wf[s_][3]); wp.z = cvtpk(wf[s_][4], wf[s_][5]); wp.w = cvtpk(wf[s_][6], wf[s_][7]);
            acc = __builtin_amdgcn_mfma_f32_16x16x32_bf16(__builtin_bit_cast(bf16x8, wp), hf, acc, 0, 0, 0);
        }
        const int row = row0 + fr;
        u32x2 o; o.x = cvtpk(acc[0], acc[1]); o.y = cvtpk(acc[2], acc[3]);
        if ((row & 255) == 255) o = (u32x2){0u, 0u};
        *(u32x2*)((kv ? VC : KC) + (size_t)row * 128 + 16 * w + 4 * fq) = o;
    }
}

namespace att {
constexpr int KS0 = 0  , VS0 = 32768  , STG = 81920, STGW = 32 * 272, IMPA = STG, IMPC = STG + 16384  , MASK = STG + 8 * STGW, LUT = MASK + 512;
static_assert(LUT + 2048 <= RING_BYTES && IMPC + 16384 <= MASK, "attention LDS");
constexpr float NEG = -1e30f, DEFER_THR = 8.0f;
__device__ __forceinline__ unsigned off_a(unsigned row, unsigned ch) { return 2048u * (row >> 3) + 512u * (ch >> 2) + 64u * (row & 7u) + 16u * ((ch & 3u) ^ ((row >> 2) & 3u)); }
__device__ __forceinline__ s16x4 vtr(const LAS unsigned char* p) { return __builtin_bit_cast(s16x4, __builtin_amdgcn_ds_read_tr16_b64_v4i16((LAS v4i16_t*)p)); }
__device__ __forceinline__ int t5_bucket(int d) {
    if (d < 16) return d;
    int b = 16;
    b += d >= 19; b += d >= 21; b += d >= 24; b += d >= 27; b += d >= 31; b += d >= 35; b += d >= 40; b += d >= 46; b += d >= 52; b += d >= 59; b += d >= 67; b += d >= 77; b += d >= 87; b += d >= 99; b += d >= 113;
    return b;
}
__device__ __forceinline__ unsigned dma_src_off(unsigned s) {
    const unsigned rhi = s >> 7, chi = (s >> 5) & 3u, rlo = (s >> 2) & 7u, cx = s & 3u, row = (rhi << 3) | rlo, x = ((row >> 2) & 3u), ch = (chi << 2) | (cx ^ x);
    return row * 256u + ch * 16u;
}
template <bool WITHV> __device__ __forceinline__ void tile_dma(LAS unsigned char* lds, int ks, int vs, const bf16_t* kb, const bf16_t* vb, const unsigned (&goff)[2], int w) {
#pragma unroll
    for (int i = 0; i < 2; ++i) {
        __builtin_amdgcn_global_load_lds((const unsigned*)((const char*)kb + goff[i]), (LAS unsigned*)(lds + KS0 + ks * 16384 + (8 * i + w) * 1024), 16, 0, 0);
        if (WITHV) __builtin_amdgcn_global_load_lds((const unsigned*)((const char*)vb + goff[i]), (LAS unsigned*)(lds + VS0 + vs * 16384 + (8 * i + w) * 1024), 16, 0, 0);
    }
}
#define ATT_WAITBAR() asm volatile("s_waitcnt vmcnt(0) lgkmcnt(0)\n\ts_barrier" ::: "memory")
__device__ __forceinline__ void qk_tiles(f32x16& s0, f32x16& s1, const LAS unsigned char* lds, const bf16x8 (&qf)[8], int lane) {
    const unsigned r32 = lane & 31, hh = lane >> 5;
    const unsigned b0 = 2048u * (r32 >> 3) + 64u * (r32 & 7u) + 16u * ((0u + hh) ^ ((r32 >> 2) & 3u)), b1 = 2048u * (r32 >> 3) + 64u * (r32 & 7u) + 16u * ((2u + hh) ^ ((r32 >> 2) & 3u));
    bf16x8 k0[8], k1[8];
#pragma unroll
    for (int ks = 0; ks < 8; ++ks) k0[ks] = *(const LAS bf16x8*)(lds + ((ks & 1) ? b1 : b0) + 512u * (ks >> 1));
#pragma unroll
    for (int ks = 0; ks < 4; ++ks) k1[ks] = *(const LAS bf16x8*)(lds + ((ks & 1) ? b1 : b0) + 8192u + 512u * (ks >> 1));
    __builtin_amdgcn_sched_barrier(0);
#pragma unroll
    for (int i = 0; i < 16; ++i) { s0[i] = 0.f; s1[i] = 0.f; }
#pragma unroll
    for (int ks = 0; ks < 8; ++ks) s0 = __builtin_amdgcn_mfma_f32_32x32x16_bf16(k0[ks], qf[ks], s0, 0, 0, 0);
    __builtin_amdgcn_sched_barrier(0);
#pragma unroll
    for (int ks = 4; ks < 8; ++ks) k1[ks] = *(const LAS bf16x8*)(lds + ((ks & 1) ? b1 : b0) + 8192u + 512u * (ks >> 1));
#pragma unroll
    for (int ks = 0; ks < 8; ++ks) s1 = __builtin_amdgcn_mfma_f32_32x32x16_bf16(k1[ks], qf[ks], s1, 0, 0, 0);
    __builtin_amdgcn_sched_barrier(0);
}
__device__ __forceinline__ bf16x8 pack8(const f32x16& p, int s) {
    u32x4 w; w.x = cvtpk(p[8 * s + 0], p[8 * s + 1]); w.y = cvtpk(p[8 * s + 2], p[8 * s + 3]); w.z = cvtpk(p[8 * s + 4], p[8 * s + 5]); w.w = cvtpk(p[8 * s + 6], p[8 * s + 7]);
    return __builtin_bit_cast(bf16x8, w);
}
__device__ __forceinline__ void pack_p(bf16x8 (&pf)[4], const f32x16& p0, const f32x16& p1) {
#pragma unroll
    for (int c = 0; c < 4; ++c) pf[c] = pack8((c >> 1) ? p1 : p0, c & 1);
}
__device__ __forceinline__ void pv_mma(f32x16 (&O)[4], const LAS unsigned char* vt, const bf16x8 (&pf)[4], int lane) {
    const unsigned hh = lane >> 5, blk = (lane >> 4) & 1, q = (lane & 15) >> 2, p = lane & 3;
    const unsigned bv0 = 64u * (4u * hh + q) + 16u * ((2u * blk + (p >> 1)) ^ ((0u + hh) & 3u)) + 8u * (p & 1u);
    const unsigned bv1 = 64u * (4u * hh + q) + 16u * ((2u * blk + (p >> 1)) ^ ((2u + hh) & 3u)) + 8u * (p & 1u);
#pragma unroll
    for (int h2 = 0; h2 < 2; ++h2) {
        bf16x8 va[2][4];
#pragma unroll
        for (int c = 0; c < 2; ++c)
#pragma unroll
            for (int dt = 0; dt < 4; ++dt) { const s16x4 lo = vtr(vt + bv0 + 2048u * (2 * (c + 2 * h2)) + 512u * dt), hi = vtr(vt + bv1 + 2048u * (2 * (c + 2 * h2) + 1) + 512u * dt); va[c][dt] = __builtin_shufflevector(lo, hi, 0, 1, 2, 3, 4, 5, 6, 7); }
        __builtin_amdgcn_sched_barrier(0);
#pragma unroll
        for (int c = 0; c < 2; ++c)
#pragma unroll
            for (int dt = 0; dt < 4; ++dt) O[dt] = __builtin_amdgcn_mfma_f32_32x32x16_bf16(va[c][dt], pf[c + 2 * h2], O[dt], 0, 0, 0);
        __builtin_amdgcn_sched_barrier(0);
    }
}
__device__ __forceinline__ float xmax32(float v) { auto rr = __builtin_amdgcn_permlane32_swap(__float_as_uint(v), __float_as_uint(v), false, false); return __builtin_fmaxf(__uint_as_float(rr[0]), __uint_as_float(rr[1])); }
__device__ __forceinline__ float xsum32(float v) { auto rr = __builtin_amdgcn_permlane32_swap(__float_as_uint(v), __float_as_uint(v), false, false); return __uint_as_float(rr[0]) + __uint_as_float(rr[1]); }
__device__ __forceinline__ int crow(int reg, int hh) { return (reg & 3) + 8 * (reg >> 2) + 4 * hh; }

template <int BR> __device__ __forceinline__ void tile_fix(f32x16& s, int pos0, int tq, int hh, bool near, bool masked, bool lanesel, const LAS float* lut) {
    if (near || masked) {
        constexpr int STEP = BR == 0 ? 16 : 1;
        int d0 = tq - (BR == 0 ? 16 * pos0 + 31 : pos0) - STEP * 4 * hh;
        asm volatile("" : "+v"(d0));
#pragma unroll
        for (int i = 0; i < 16; ++i) {
            const int dist = d0 - STEP * ((i & 3) + 8 * (i >> 2));
            bool ok = dist >= 0; if (BR == 2) ok = ok && dist < 512; if (BR == 1) ok = ok && lanesel;
            float v = s[i];
            if (near) { const int dc = dist < 0 ? 0 : (dist > 127 ? 127 : dist); v += lut[dc]; }
            s[i] = ok ? v : NEG;
        }
    }
}

template <int BR> __device__ __forceinline__ void online_front(f32x16 (&O)[4], float& m, float& l, bf16x8 (&pf)[4], const LAS unsigned char* kt, const bf16x8 (&qf)[8], int lane, int pos0, int tq, bool near, bool masked, bool lanesel, const LAS float* lut) {
    const int hh = lane >> 5;
    f32x16 s0, s1; qk_tiles(s0, s1, kt, qf, lane);
    tile_fix<BR>(s0, pos0, tq, hh, near, masked, true, lut); tile_fix<BR>(s1, pos0 + 32, tq, hh, near, masked, true, lut);
    float mx = NEG;
#pragma unroll
    for (int i = 0; i < 16; ++i) { mx = __builtin_fmaxf(mx, s0[i]); mx = __builtin_fmaxf(mx, s1[i]); }
    mx = lanesel ? mx : NEG;
    mx = xmax32(mx);
    const bool grow = mx > m + DEFER_THR;
    if (__any(grow)) {
        const float mn = grow ? mx : m, alpha = __builtin_amdgcn_exp2f(m - mn); m = mn; l *= alpha;
#pragma unroll
        for (int dt = 0; dt < 4; ++dt)
#pragma unroll
            for (int i = 0; i < 16; ++i) O[dt][i] *= alpha;
    }
    const float mu = lanesel ? __builtin_fmaxf(m, -1e20f) : 1e30f;
    float ps = 0.f;
#pragma unroll
    for (int i = 0; i < 16; ++i) { s0[i] = __builtin_amdgcn_exp2f(s0[i] - mu); s1[i] = __builtin_amdgcn_exp2f(s1[i] - mu); ps += s0[i] + s1[i]; }
    l += ps;
    pack_p(pf, s0, s1);
}

__device__ __forceinline__ unsigned stg_off(int row, int dt, int rg, int hh) { return (unsigned)row * 272u + (unsigned)((4 * dt + rg) * 16) + 8u * hh; }
template <bool ACCUM> __device__ __forceinline__ void stage_out(LAS unsigned char* stg, const f32x16 (&O)[4], float scale, int lane) {
    const int row = lane & 31, hh = lane >> 5;
#pragma unroll
    for (int dt = 0; dt < 4; ++dt)
#pragma unroll
        for (int rg = 0; rg < 4; ++rg) {
            LAS u32x2* p = (LAS u32x2*)(stg + stg_off(row, dt, rg, hh));
            float a0 = O[dt][4 * rg] * scale, a1 = O[dt][4 * rg + 1] * scale, a2 = O[dt][4 * rg + 2] * scale, a3 = O[dt][4 * rg + 3] * scale;
            if (ACCUM) { const u32x2 old = *p; a0 += bf_lo(old.x); a1 += bf_hi(old.x); a2 += bf_lo(old.y); a3 += bf_hi(old.y); }
            u32x2 w; w.x = cvtpk(a0, a1); w.y = cvtpk(a2, a3); *p = w;
        }
}

template <int SKIP> __device__ __forceinline__ void attn_phase(const Frame& F, const bf16_t* Q, const bf16_t* KV, const bf16_t* KC, const bf16_t* VC, const float* gates, const float* rel_bias, bf16_t* Oout) {
    LAS unsigned char* lds = F.lds;
    const int tid = F.tid, lane = F.lane, w = F.wave, hh = lane >> 5, qrow = lane & 31, ql = qrow >> 2, r = qrow & 3;
    LAS float* impA = (LAS float*)(lds + IMPA); LAS float* impC = (LAS float*)(lds + IMPC);
    LAS unsigned char* maskb = lds + MASK; LAS float* lutall = (LAS float*)(lds + LUT);
    LAS unsigned char* stg = lds + STG + w * STGW;
#define SEC_BEGIN ln = lane; asm volatile("" : "+v"(ln)); td = w * 64 + ln
    const int nun = F.G == 256 ? 2 : (512 - (int)blockIdx.x + F.G - 1) / F.G;
    for (int ui = 0; ui < nun; ++ui) {
        const int unit = F.G == 256 ? ((int)(blockIdx.x & 7) * 64 + (ui == 0 ? 63 - (int)(blockIdx.x >> 3) : (int)(blockIdx.x >> 3))) : (int)blockIdx.x + ui * F.G;
        int ln, td;
        const int bg = unit >> 6, qi = unit & 63, b = bg >> 2, g = bg & 3, t0 = qi * 64;
        const int tq = t0 + 8 * w + ql; const size_t trow = (size_t)b * SEQ + tq; const int head = g * 4 + r;
        const bf16_t* kcb = KC + (size_t)bg * 256 * 128; const bf16_t* vcb = VC + (size_t)bg * 256 * 128;
        const bf16_t* ksb = KV + (size_t)((2 * 2 + b) * 4 + g) * 4096 * 128; const bf16_t* vsb = KV + (size_t)((3 * 2 + b) * 4 + g) * 4096 * 128;
        const bf16_t* kwb = KV + (size_t)((4 * 2 + b) * 4 + g) * 4096 * 128; const bf16_t* vwb = KV + (size_t)((5 * 2 + b) * 4 + g) * 4096 * 128;
        __syncthreads();
        SEC_BEGIN;
        unsigned goff[2];
#pragma unroll
        for (int i = 0; i < 2; ++i) goff[i] = dma_src_off((unsigned)((8 * i + w) * 64 + ln));
        int st = 0;
        tile_dma<false>(lds, st, st, kcb, nullptr, goff, w);
        { const int rr = td >> 7, d = td & 127; const int hd = g * 4 + rr; lutall[td] = (rel_bias[t5_bucket(d) * 16 + hd] - rel_bias[31 * 16 + hd]) * LOG2E; }
        for (int i = td; i < 8192; i += 512) ((LAS float*)(lds + IMPA))[i] = 0.f;
        const LAS float* lut = lutall + r * 128;
        bf16x8 qf[8];
#pragma unroll
        for (int ks = 0; ks < 8; ++ks) qf[ks] = *(const bf16x8*)(Q + trow * DM + head * 128 + 16 * ks + 8 * hh);
        const float g0 = gates[trow * 48 + head], g1 = gates[trow * 48 + 16 + head], g2 = gates[trow * 48 + 32 + head];
        const int tq_lo = t0 + 8 * w, tq_hi = tq_lo + 7;
        const int nbc = (4 * qi + 2) / 64 + 1;
        float m = NEG, l = 0.f;
        for (int jb = 0; jb < nbc; ++jb) {
            ATT_WAITBAR();
            if (jb + 1 < nbc) tile_dma<false>(lds, st ^ 1, st ^ 1, kcb + (size_t)(jb + 1) * 64 * 128, nullptr, goff, w);
            else tile_dma<true>(lds, st ^ 1, st ^ 1, kcb, vcb, goff, w);
            const LAS unsigned char* sl = lds + KS0 + st * 16384; const LAS unsigned char* vl = lds + VS0 + st * 16384; (void)vl; st ^= 1;
            const int c0 = 64 * jb;
            if (!(SKIP & 4) && 16 * c0 + 31 <= tq_hi) {
                f32x16 s0, s1; qk_tiles(s0, s1, sl, qf, ln);
                const bool near0 = tq_lo - (16 * (c0 + 31) + 31) < 113, near1 = tq_lo - (16 * (c0 + 63) + 31) < 113;
                const bool mk0 = 16 * (c0 + 31) + 31 > tq_lo, mk1 = 16 * (c0 + 63) + 31 > tq_lo;
                tile_fix<0>(s0, c0, tq, hh, near0, mk0, true, lut); tile_fix<0>(s1, c0 + 32, tq, hh, near1, mk1, true, lut);
                float mx = NEG;
#pragma unroll
                for (int i = 0; i < 16; ++i) { mx = __builtin_fmaxf(mx, s0[i]); mx = __builtin_fmaxf(mx, s1[i]); }
                mx = xmax32(mx);
                const float mn = __builtin_fmaxf(m, mx), alpha = __builtin_amdgcn_exp2f(m - mn); m = mn;
                const float mu = __builtin_fmaxf(mn, -1e20f);
                float ps = 0.f;
#pragma unroll
                for (int i = 0; i < 16; ++i) { ps += __builtin_amdgcn_exp2f(s0[i] - mu); ps += __builtin_amdgcn_exp2f(s1[i] - mu); }
                l = l * alpha + ps;
            }
        }
        l = xsum32(l);
        const float invl = l > 0.f ? 1.0f / l : 0.f;
        f32x16 O[4];
#pragma unroll
        for (int dt = 0; dt < 4; ++dt)
#pragma unroll
            for (int i = 0; i < 16; ++i) O[dt][i] = 0.f;
        SEC_BEGIN;
        for (int jb = 0; jb < nbc; ++jb) {
            ATT_WAITBAR();
            if (jb + 1 < nbc) tile_dma<true>(lds, st ^ 1, st ^ 1, kcb + (size_t)(jb + 1) * 64 * 128, vcb + (size_t)(jb + 1) * 64 * 128, goff, w);
            else tile_dma<true>(lds, st ^ 1, st ^ 1, ksb, vsb, goff, w);
            const LAS unsigned char* sl = lds + KS0 + st * 16384; const LAS unsigned char* vl = lds + VS0 + st * 16384; st ^= 1;
            const int c0 = 64 * jb;
            if (!(SKIP & 4) && 16 * c0 + 31 <= tq_hi) {
                f32x16 s0, s1; qk_tiles(s0, s1, sl, qf, ln);
                const bool near0 = tq_lo - (16 * (c0 + 31) + 31) < 113, near1 = tq_lo - (16 * (c0 + 63) + 31) < 113;
                const bool mk0 = 16 * (c0 + 31) + 31 > tq_lo, mk1 = 16 * (c0 + 63) + 31 > tq_lo;
                tile_fix<0>(s0, c0, tq, hh, near0, mk0, true, lut); tile_fix<0>(s1, c0 + 32, tq, hh, near1, mk1, true, lut);
                const float mu = __builtin_fmaxf(m, -1e20f);
#pragma unroll
                for (int i = 0; i < 16; ++i) { s0[i] = __builtin_amdgcn_exp2f(s0[i] - mu) * invl; s1[i] = __builtin_amdgcn_exp2f(s1[i] - mu) * invl; }
#pragma unroll
                for (int kt = 0; kt < 2; ++kt)
#pragma unroll
                    for (int rg = 0; rg < 4; ++rg) {
                        const f32x16& p = kt ? s1 : s0;
                        float gs = (p[4 * rg] + p[4 * rg + 1]) + (p[4 * rg + 2] + p[4 * rg + 3]); float cy = p[4 * rg + 3];
                        gs += __shfl_xor(gs, 1); gs += __shfl_xor(gs, 2); cy += __shfl_xor(cy, 1); cy += __shfl_xor(cy, 2);
                        const int j = 16 * jb + 8 * kt + 2 * rg + hh;
                        if (r == 0) { impA[(8 * w + ql) * 64 + j] = gs; if (j + 1 < 64) impC[(8 * w + ql) * 64 + j + 1] = cy; }
                    }
                { bf16x8 pfc[4]; pack_p(pfc, s0, s1); pv_mma(O, vl, pfc, ln); }
            }
        }
        __syncthreads();
        SEC_BEGIN;
        {
            for (int i = td; i < 4096; i += 512) { const int j = i & 63;
                const bool forced = (j == 0) || (j == qi) || (j == qi - 1); const float imp = impA[i] + impC[i];
                impA[i] = forced ? 1e4f : (j <= qi ? imp : -1.0f); }
            __syncthreads();
            if (w == 0) {
                const int q = ln; unsigned L[16];
#pragma unroll
                for (int s_ = 0; s_ < 16; ++s_) L[s_] = 0u;
#define TK_CE(a_, b_) do { const unsigned h_ = (a_) > (b_) ? (a_) : (b_); (b_) = (a_) > (b_) ? (b_) : (a_); (a_) = h_; } while (0)
#pragma unroll
                for (int g_ = 0; g_ < 4; ++g_) { unsigned K_[16];
#pragma unroll
                    for (int c = 0; c < 4; ++c) { const f32x4 v = *(const LAS f32x4*)(impA + q * 64 + 16 * g_ + 4 * c);
#pragma unroll
                        for (int x = 0; x < 4; ++x) { const unsigned u_ = __float_as_uint(v[x]); const unsigned o_ = (u_ & 0x80000000u) ? ~u_ : (u_ | 0x80000000u); K_[4 * c + x] = (o_ & ~0x3Fu) | (unsigned)(63 - (16 * g_ + 4 * c + x)); } }
                    TK_CE(K_[0], K_[1]); TK_CE(K_[2], K_[3]); TK_CE(K_[4], K_[5]); TK_CE(K_[6], K_[7]); TK_CE(K_[8], K_[9]); TK_CE(K_[10], K_[11]); TK_CE(K_[12], K_[13]); TK_CE(K_[14], K_[15]); TK_CE(K_[0], K_[2]); TK_CE(K_[1], K_[3]); TK_CE(K_[4], K_[6]); TK_CE(K_[5], K_[7]); TK_CE(K_[8], K_[10]); TK_CE(K_[9], K_[11]); TK_CE(K_[12], K_[14]); TK_CE(K_[13], K_[15]); TK_CE(K_[1], K_[2]); TK_CE(K_[5], K_[6]); TK_CE(K_[9], K_[10]); TK_CE(K_[13], K_[14]); TK_CE(K_[0], K_[4]); TK_CE(K_[1], K_[5]); TK_CE(K_[2], K_[6]); TK_CE(K_[3], K_[7]); TK_CE(K_[8], K_[12]); TK_CE(K_[9], K_[13]); TK_CE(K_[10], K_[14]); TK_CE(K_[11], K_[15]); TK_CE(K_[2], K_[4]); TK_CE(K_[3], K_[5]); TK_CE(K_[10], K_[12]); TK_CE(K_[11], K_[13]); TK_CE(K_[1], K_[2]); TK_CE(K_[3], K_[4]); TK_CE(K_[5], K_[6]); TK_CE(K_[9], K_[10]); TK_CE(K_[11], K_[12]); TK_CE(K_[13], K_[14]); TK_CE(K_[0], K_[8]); TK_CE(K_[1], K_[9]); TK_CE(K_[2], K_[10]); TK_CE(K_[3], K_[11]); TK_CE(K_[4], K_[12]); TK_CE(K_[5], K_[13]); TK_CE(K_[6], K_[14]); TK_CE(K_[7], K_[15]); TK_CE(K_[4], K_[8]); TK_CE(K_[5], K_[9]); TK_CE(K_[6], K_[10]); TK_CE(K_[7], K_[11]); TK_CE(K_[2], K_[4]); TK_CE(K_[3], K_[5]); TK_CE(K_[6], K_[8]); TK_CE(K_[7], K_[9]); TK_CE(K_[10], K_[12]); TK_CE(K_[11], K_[13]); TK_CE(K_[1], K_[2]); TK_CE(K_[3], K_[4]); TK_CE(K_[5], K_[6]); TK_CE(K_[7], K_[8]); TK_CE(K_[9], K_[10]); TK_CE(K_[11], K_[12]); TK_CE(K_[13], K_[14]);
#pragma unroll
                    for (int i = 0; i < 16; ++i) L[i] = L[i] > K_[15 - i] ? L[i] : K_[15 - i];
                    TK_CE(L[0], L[8]); TK_CE(L[1], L[9]); TK_CE(L[2], L[10]); TK_CE(L[3], L[11]); TK_CE(L[4], L[12]); TK_CE(L[5], L[13]); TK_CE(L[6], L[14]); TK_CE(L[7], L[15]); TK_CE(L[0], L[4]); TK_CE(L[1], L[5]); TK_CE(L[2], L[6]); TK_CE(L[3], L[7]); TK_CE(L[8], L[12]); TK_CE(L[9], L[13]); TK_CE(L[10], L[14]); TK_CE(L[11], L[15]); TK_CE(L[0], L[2]); TK_CE(L[1], L[3]); TK_CE(L[4], L[6]); TK_CE(L[5], L[7]); TK_CE(L[8], L[10]); TK_CE(L[9], L[11]); TK_CE(L[12], L[14]); TK_CE(L[13], L[15]); TK_CE(L[0], L[1]); TK_CE(L[2], L[3]); TK_CE(L[4], L[5]); TK_CE(L[6], L[7]); TK_CE(L[8], L[9]); TK_CE(L[10], L[11]); TK_CE(L[12], L[13]); TK_CE(L[14], L[15]); }
#undef TK_CE
                unsigned long long bits = 0ull;
#pragma unroll
                for (int s_ = 0; s_ < 16; ++s_) bits |= 1ull << (63u - (L[s_] & 63u));
                *(LAS unsigned long long*)(maskb + q * 8) = bits;
            }
            __syncthreads();
        }
        stage_out<false>(stg, O, g0, ln);
        const unsigned long long causal_mask = qi >= 63 ? ~0ull : ((2ull << qi) - 1ull);
        const unsigned long long mymask = *(const LAS unsigned long long*)(maskb + (8 * w + ql) * 8) & causal_mask;
        unsigned long long uni = *(const LAS unsigned long long*)(maskb + (ln & 63) * 8) & causal_mask;
#pragma unroll
        for (int o = 1; o < 64; o <<= 1) { const unsigned lo = __shfl_xor((unsigned)uni, o), hi = __shfl_xor((unsigned)(uni >> 32), o); uni |= ((unsigned long long)hi << 32) | lo; }
        unsigned long long wuni = mymask;
#pragma unroll
        for (int o = 4; o < 32; o <<= 1) { const unsigned lo = __shfl_xor((unsigned)wuni, o), hi = __shfl_xor((unsigned)(wuni >> 32), o); wuni |= ((unsigned long long)hi << 32) | lo; }
        uni = ((unsigned long long)__builtin_amdgcn_readfirstlane((unsigned)(uni >> 32)) << 32) | (unsigned)__builtin_amdgcn_readfirstlane((unsigned)uni);
        wuni = ((unsigned long long)__builtin_amdgcn_readfirstlane((unsigned)(wuni >> 32)) << 32) | (unsigned)__builtin_amdgcn_readfirstlane((unsigned)wuni);
        const int jlo = qi >= 8 ? qi - 8 : 0;
#define ATT_STEP(BR_, need_, pos0_, near_, masked_, lanesel_) do { \
            const LAS unsigned char* kt_ = lds + KS0 + kc * 16384; const LAS unsigned char* vt_ = lds + VS0 + vc * 16384; \
            int lq = ln; asm volatile("" : "+v"(lq));     \
            if (!late_c) { if (need_) { bf16x8 pf_[4]; online_front<BR_>(O, m, l, pf_, kt_, qf, lq, pos0_, tq, near_, masked_, lanesel_, lut); pv_mma(O, vt_, pf_, lq); } } \
            else { if (pend) pv_mma(O, lds + VS0 + vprev * 16384, pfl, lq); \
                   if (need_) online_front<BR_>(O, m, l, pfl, kt_, qf, lq, pos0_, tq, near_, masked_, lanesel_, lut); \
                   pend = (need_); vprev = vc; } \
            kc ^= 1; vc = vc == 2 ? 0 : vc + 1; } while (0)
#define ATT_FLUSH() do { if (late_c && pend) { int lq = ln; asm volatile("" : "+v"(lq)); pv_mma(O, lds + VS0 + vprev * 16384, pfl, lq); } pend = false; } while (0)
#define ATT_SELWIN(LATE_) do { constexpr bool late_c = LATE_; \
        int kc = st, vc = st; \
        bf16x8 pfl[4]; bool pend = false; int vprev = 0; \
        SEC_BEGIN; \
        { \
            m = NEG; l = 0.f; \
_Pragma("unroll") \
            for (int dt = 0; dt < 4; ++dt) \
_Pragma("unroll") \
                for (int i = 0; i < 16; ++i) O[dt][i] = 0.f; \
            unsigned long long rem = uni; \
            int j = __builtin_ctzll(rem); rem &= rem - 1; \
            for (;;) { \
                ATT_WAITBAR(); \
                const int jn = rem ? __builtin_ctzll(rem) : -1; \
                const int kn = kc ^ 1, vn = vc == 2 ? 0 : vc + 1; \
                if (jn >= 0) { rem &= rem - 1; tile_dma<true>(lds, kn, vn, ksb + (size_t)jn * 64 * 128, vsb + (size_t)jn * 64 * 128, goff, w); } \
                else tile_dma<true>(lds, kn, vn, kwb + (size_t)jlo * 64 * 128, vwb + (size_t)jlo * 64 * 128, goff, w); \
                const bool need = !(SKIP & 1) && ((wuni >> j) & 1ull); const bool lanesel = (mymask >> j) & 1ull; \
                ATT_STEP(1, need, 64 * j, j >= qi - 2, j == qi, lanesel); \
                if (jn < 0) break; \
                j = jn; \
            } \
            ATT_FLUSH(); \
            l = xsum32(l); \
            stage_out<true>(stg, O, l > 0.f ? g1 / l : 0.f, ln); \
        } \
        SEC_BEGIN; \
        { \
            m = NEG; l = 0.f; \
_Pragma("unroll") \
            for (int dt = 0; dt < 4; ++dt) \
_Pragma("unroll") \
                for (int i = 0; i < 16; ++i) O[dt][i] = 0.f; \
            for (int j = jlo; j <= qi; ++j) { \
                ATT_WAITBAR(); \
                const int kn = kc ^ 1, vn = vc == 2 ? 0 : vc + 1; \
                if (j + 1 <= qi) tile_dma<true>(lds, kn, vn, kwb + (size_t)(j + 1) * 64 * 128, vwb + (size_t)(j + 1) * 64 * 128, goff, w); \
                const bool masked = (j == qi) || (j == qi - 8); const bool need = !(SKIP & 2); \
                ATT_STEP(2, need, 64 * j, j >= qi - 2, masked, true); \
            } \
            ATT_FLUSH(); \
            l = xsum32(l); \
            stage_out<true>(stg, O, l > 0.f ? g2 / l : 0.f, ln); \
        } \
        } while (0)
        if (w >= 4) ATT_SELWIN(true); else ATT_SELWIN(false);
#undef ATT_SELWIN
#undef ATT_STEP
#undef ATT_FLUSH
        SEC_BEGIN;
        LDS_WAIT(); asm volatile("" ::: "memory");
#pragma unroll
        for (int i = 0; i < 8; ++i) {
            const int idx = ln + 64 * i, row = idx >> 4, ch = idx & 15;
            const u32x4 v = *(const LAS u32x4*)(stg + row * 272 + ch * 16);
            const int rql = row >> 2, rr = row & 3;
            *(u32x4*)(Oout + ((size_t)b * SEQ + t0 + 8 * w + rql) * DM + (g * 4 + rr) * 128 + ch * 8) = v;
        }
    }
}
#undef SEC_BEGIN
}


__device__ __forceinline__ void xcd_align(unsigned* cnt, unsigned nloc, int wave, int lane) {
    asm volatile("" ::: "memory"); __builtin_amdgcn_s_barrier(); asm volatile("" ::: "memory");
    if (wave == 0) {
        if (lane == 0) { (void)__hip_atomic_fetch_add(cnt, 1u, RLX_AGENT); }
        unsigned sp = 0u;
        while ((unsigned)__builtin_amdgcn_readfirstlane((int)__hip_atomic_load(cnt, RLX_AGENT)) < nloc) { __builtin_amdgcn_s_sleep(1); if (++sp > 40000u) break; }
    }
    asm volatile("" ::: "memory"); __builtin_amdgcn_s_barrier(); asm volatile("" ::: "memory");
}
namespace peer {
constexpr int LISTS = 0, LISTB = 139264  , IDXO = 90112, GATEO = 106496, SUO = 122880;
constexpr int XQO = 0, KEYO = 65536, HISTO = 81920, SXO = 86016;
static_assert(SUO + 16384 <= LISTB && LISTB + 16384 <= RING_BYTES && SXO + 256 + 2048 <= IDXO, "PEER tail LDS map");
__device__ __forceinline__ unsigned ford(float f) { const unsigned u = __float_as_uint(f); return (u & 0x80000000u) ? ~u : (u | 0x80000000u); }
__device__ __forceinline__ float finv(unsigned k) { return __uint_as_float((k & 0x80000000u) ? (k & 0x7fffffffu) : ~k); }
#define INS16(L, x) do { unsigned _x = (x); _Pragma("unroll") for (int _s = 0; _s < 16; ++_s) { const unsigned _h = L[_s] > _x ? L[_s] : _x; _x = L[_s] > _x ? _x : L[_s]; L[_s] = _h; } } while (0)

template <int TSKIP> __device__ __forceinline__ void tail_phase(const Frame& F, const Args& a, int layer, const bf16_t* SC, const bf16_t* Hin, const float* ssq, bf16_t* Hb, float* ssqo, float* outp, const unsigned char* Ub, const unsigned char* Vb, const float* Usc, const float* Vsc, unsigned* align_cnt, unsigned nloc) {
    LAS unsigned char* lds = F.lds; const int w = F.wave;
    LAS float* sc = (LAS float*)lds; LAS unsigned* lists = (LAS unsigned*)(lds + LISTS); LAS int* idxs = (LAS int*)(lds + IDXO); LAS float* gts = (LAS float*)(lds + GATEO); LAS float* sus = (LAS float*)(lds + SUO);
    const float* gain = a.ffn_norm + (size_t)layer * DM;
    for (int tile = blockIdx.x; tile < T / 32; tile += F.G) {
        const int t0 = tile * 32;
        int lane = F.lane; asm volatile("" : "+v"(lane)); const int tid = w * 64 + lane;
        unsigned L[16];
#pragma unroll
        for (int s = 0; s < 16; ++s) L[s] = 0u;
#define TK_CE(a_, b_) do { const unsigned h_ = (a_) > (b_) ? (a_) : (b_); (b_) = (a_) > (b_) ? (b_) : (a_); (a_) = h_; } while (0)
#define TK_SCAN() do { _Pragma("unroll") for (int g = 0; g < ((TSKIP & 4) ? 0 : 8); ++g) { unsigned K_[16]; \
            _Pragma("unroll") for (int i = 0; i < 8; ++i) { const unsigned dw = scw[tid * 65 + 8 * g + i]; \
                K_[2 * i] = (ford(bf_lo(dw)) & ~0x7Fu) | (unsigned)(127 - (16 * g + 2 * i)); K_[2 * i + 1] = (ford(bf_hi(dw)) & ~0x7Fu) | (unsigned)(127 - (16 * g + 2 * i + 1)); } \
            SORT_NET \
            _Pragma("unroll") for (int i = 0; i < 16; ++i) L[i] = L[i] > K_[15 - i] ? L[i] : K_[15 - i]; \
            BITONIC_NET } } while (0)
#define SORT_NET TK_CE(K_[0], K_[1]); TK_CE(K_[2], K_[3]); TK_CE(K_[4], K_[5]); TK_CE(K_[6], K_[7]); TK_CE(K_[8], K_[9]); TK_CE(K_[10], K_[11]); TK_CE(K_[12], K_[13]); TK_CE(K_[14], K_[15]); TK_CE(K_[0], K_[2]); TK_CE(K_[1], K_[3]); TK_CE(K_[4], K_[6]); TK_CE(K_[5], K_[7]); TK_CE(K_[8], K_[10]); TK_CE(K_[9], K_[11]); TK_CE(K_[12], K_[14]); TK_CE(K_[13], K_[15]); TK_CE(K_[1], K_[2]); TK_CE(K_[5], K_[6]); TK_CE(K_[9], K_[10]); TK_CE(K_[13], K_[14]); TK_CE(K_[0], K_[4]); TK_CE(K_[1], K_[5]); TK_CE(K_[2], K_[6]); TK_CE(K_[3], K_[7]); TK_CE(K_[8], K_[12]); TK_CE(K_[9], K_[13]); TK_CE(K_[10], K_[14]); TK_CE(K_[11], K_[15]); TK_CE(K_[2], K_[4]); TK_CE(K_[3], K_[5]); TK_CE(K_[10], K_[12]); TK_CE(K_[11], K_[13]); TK_CE(K_[1], K_[2]); TK_CE(K_[3], K_[4]); TK_CE(K_[5], K_[6]); TK_CE(K_[9], K_[10]); TK_CE(K_[11], K_[12]); TK_CE(K_[13], K_[14]); TK_CE(K_[0], K_[8]); TK_CE(K_[1], K_[9]); TK_CE(K_[2], K_[10]); TK_CE(K_[3], K_[11]); TK_CE(K_[4], K_[12]); TK_CE(K_[5], K_[13]); TK_CE(K_[6], K_[14]); TK_CE(K_[7], K_[15]); TK_CE(K_[4], K_[8]); TK_CE(K_[5], K_[9]); TK_CE(K_[6], K_[10]); TK_CE(K_[7], K_[11]); TK_CE(K_[2], K_[4]); TK_CE(K_[3], K_[5]); TK_CE(K_[6], K_[8]); TK_CE(K_[7], K_[9]); TK_CE(K_[10], K_[12]); TK_CE(K_[11], K_[13]); TK_CE(K_[1], K_[2]); TK_CE(K_[3], K_[4]); TK_CE(K_[5], K_[6]); TK_CE(K_[7], K_[8]); TK_CE(K_[9], K_[10]); TK_CE(K_[11], K_[12]); TK_CE(K_[13], K_[14]);
#define BITONIC_NET TK_CE(L[0], L[8]); TK_CE(L[1], L[9]); TK_CE(L[2], L[10]); TK_CE(L[3], L[11]); TK_CE(L[4], L[12]); TK_CE(L[5], L[13]); TK_CE(L[6], L[14]); TK_CE(L[7], L[15]); TK_CE(L[0], L[4]); TK_CE(L[1], L[5]); TK_CE(L[2], L[6]); TK_CE(L[3], L[7]); TK_CE(L[8], L[12]); TK_CE(L[9], L[13]); TK_CE(L[10], L[14]); TK_CE(L[11], L[15]); TK_CE(L[0], L[2]); TK_CE(L[1], L[3]); TK_CE(L[4], L[6]); TK_CE(L[5], L[7]); TK_CE(L[8], L[10]); TK_CE(L[9], L[11]); TK_CE(L[12], L[14]); TK_CE(L[13], L[15]); TK_CE(L[0], L[1]); TK_CE(L[2], L[3]); TK_CE(L[4], L[5]); TK_CE(L[6], L[7]); TK_CE(L[8], L[9]); TK_CE(L[10], L[11]); TK_CE(L[12], L[13]); TK_CE(L[14], L[15]);
        {
            LAS unsigned* scw = (LAS unsigned*)lds;
            u32x4 scv[16];
#pragma unroll
            for (int k = 0; k < 16; ++k) { const int f = tid + 512 * k, tok = f >> 8, hp = (f >> 4) & 15, q = f & 15; scv[k] = *(const u32x4*)(SC + (size_t)(t0 + tok) * DM + hp * 128 + 8 * q); }
            __syncthreads();
#pragma unroll
            for (int k = 0; k < 16; ++k) { const int f = tid + 512 * k, tok = f >> 8, hp = (f >> 4) & 15, q = f & 15; LAS unsigned* d = scw + (tok * 16 + hp) * 65 + 4 * q; d[0] = scv[k][0]; d[1] = scv[k][1]; d[2] = scv[k][2]; d[3] = scv[k][3]; }
            __syncthreads();
            TK_SCAN();
        }
#undef SORT_NET
#undef BITONIC_NET
#undef TK_CE
#undef TK_SCAN
        __syncthreads();
        {
            LAS unsigned* lw = (LAS unsigned*)(lds + ((tid & 1) ? LISTB : KEYO)) + (tid >> 1) * 16;
#pragma unroll
            for (int c = 0; c < 4; ++c) *(LAS u32x4*)(lw + 4 * c) = (u32x4){L[4 * c], L[4 * c + 1], L[4 * c + 2], L[4 * c + 3]};
        }
        __syncthreads();
        LAS unsigned char* xql = lds + XQO; LAS float* sxl = (LAS float*)(lds + SXO); LAS unsigned* keys = (LAS unsigned*)(lds + KEYO); LAS unsigned* hist = (LAS unsigned*)(lds + HISTO);
        if (tid < 256) { if (!(TSKIP & 16)) {
            const int tok = tid >> 3, h = tid & 7; const LAS unsigned* la = (const LAS unsigned*)(lds + KEYO) + tid * 16; const LAS unsigned* lb = (const LAS unsigned*)(lds + LISTB) + tid * 16;
            float s1[16], s2[16];
#pragma unroll
            for (int c = 0; c < 4; ++c) { const u32x4 va_ = *(const LAS u32x4*)(la + 4 * c), vb_ = *(const LAS u32x4*)(lb + 4 * c);
#pragma unroll
                for (int x = 0; x < 4; ++x) { s1[4 * c + x] = finv(va_[x] & ~0x7Fu); s2[4 * c + x] = finv(vb_[x] & ~0x7Fu); } }
            unsigned C[16];
#pragma unroll
            for (int s = 0; s < 16; ++s) C[s] = 0u;
#pragma unroll
            for (int x = 0; x < 16; ++x)
#pragma unroll
                for (int y = 0; y < 16; ++y) if ((x + 1) * (y + 1) <= 16) { const unsigned key = (ford(s1[x] + s2[y]) & ~0xFFu) | (unsigned)(255 - (x * 16 + y)); INS16(C, key); }
            float ts[16]; float sum = 0.f; const float mx = finv(C[0] & ~0xFFu);
#pragma unroll
            for (int s = 0; s < 16; ++s) { ts[s] = __builtin_amdgcn_exp2f((finv(C[s] & ~0xFFu) - mx) * LOG2E); sum += ts[s]; }
            const float inv = 1.0f / sum;
#pragma unroll
            for (int s = 0; s < 16; ++s) { const int pos = 255 - (int)(C[s] & 0xFFu), x = pos >> 4, y = pos & 15;
                const int i1 = 127 - (int)(la[x] & 0x7Fu), i2 = 127 - (int)(lb[y] & 0x7Fu);
                const int e = i1 * 128 + i2; idxs[tok * 128 + h * 16 + s] = e; gts[tok * 128 + h * 16 + s] = ts[s] * inv * Vsc[e] * 256.0f; sus[tok * 128 + h * 16 + s] = Usc[e]; }
        } }
        else if (!(TSKIP & 8)) {
            int ln = lane; asm volatile("" : "+v"(ln));
            f32x4 gpre[8];
#pragma unroll
            for (int m = 0; m < 8; ++m) gpre[m] = *(const f32x4*)(gain + 256 * m + 4 * ln);
            for (int bt = 0; bt < 2; ++bt) {
                u32x2 hpre[4][8]; float ppre[4];
#pragma unroll
                for (int it4 = 0; it4 < 4; ++it4) { const size_t t = (size_t)t0 + (w - 4) + 4 * (4 * bt + it4);
#pragma unroll
                    for (int m = 0; m < 8; ++m) hpre[it4][m] = *(const u32x2*)(Hin + t * DM + 256 * m + 4 * ln);
                    ppre[it4] = ln < 32 ? ssq[t * 32 + ln] : 0.f; }
#pragma unroll
                for (int it4 = 0; it4 < 4; ++it4) {
                    const int tl = (w - 4) + 4 * (4 * bt + it4);
            float pss = ppre[it4]; pss = wave_sum(pss);
            const float rstd = rsqrtf(pss * (1.0f / DM) + EPS);
            {
                float xv[2][16]; float am = 0.f;
#pragma unroll
                for (int j = 0; j < 2; ++j)
#pragma unroll
                    for (int i = 0; i < 4; ++i) { const u32x2 hb_ = hpre[it4][i + 4 * j]; const f32x4 h4 = (f32x4){bf_lo(hb_.x), bf_hi(hb_.x), bf_lo(hb_.y), bf_hi(hb_.y)}, g4 = gpre[i + 4 * j];
#pragma unroll
                        for (int c = 0; c < 4; ++c) { xv[j][4 * i + c] = h4[c] * rstd * g4[c]; am = __builtin_fmaxf(am, __builtin_fabsf(xv[j][4 * i + c])); } }
                am = __builtin_fmaxf(am, dpp_f<0xB1>(am)); am = __builtin_fmaxf(am, dpp_f<0x4E>(am)); am = __builtin_fmaxf(am, dpp_f<0x141>(am)); am = __builtin_fmaxf(am, dpp_f<0x140>(am));
                am = __builtin_fmaxf(__builtin_fmaxf(__builtin_bit_cast(float, __builtin_amdgcn_readlane(__builtin_bit_cast(int, am), 0)), __builtin_bit_cast(float, __builtin_amdgcn_readlane(__builtin_bit_cast(int, am), 16))),
                                     __builtin_fmaxf(__builtin_bit_cast(float, __builtin_amdgcn_readlane(__builtin_bit_cast(int, am), 32)), __builtin_bit_cast(float, __builtin_amdgcn_readlane(__builtin_bit_cast(int, am), 48))));
                const float qs = am > 0.f ? 119.0f / am : 1.0f;
                if (ln == 0) sxl[tl] = am > 0.f ? am * (1.0f / 119.0f) : 1.0f;
                float sx = 0.f; u32x4 ph, pl;
#pragma unroll
                for (int i = 0; i < 4; ++i) { unsigned wh = 0u, wl = 0u;
#pragma unroll
                    for (int c = 0; c < 4; ++c) { const int x0 = (int)__builtin_rintf(xv[0][4 * i + c] * qs), x1 = (int)__builtin_rintf(xv[1][4 * i + c] * qs); sx += (float)(x0 + x1);
                        const int l0 = ((x0 + 8) & 15) - 8, l1 = ((x1 + 8) & 15) - 8, h0 = (x0 - l0) >> 4, h1 = (x1 - l1) >> 4;
                        wh |= (((unsigned)h0 & 15u) | (((unsigned)h1 & 15u) << 4)) << (8 * c); wl |= (((unsigned)l0 & 15u) | (((unsigned)l1 & 15u) << 4)) << (8 * c); }
                    ph[i] = wh; pl[i] = wl; }
                *(LAS u32x4*)(xql + tl * 2048 + 16 * ln) = ph; *(LAS u32x4*)(xql + tl * 2048 + 1024 + 16 * ln) = pl;
                sx = wave_sum(sx);
                if (ln == 0) sxl[32 + tl] = 0.5f * sx;
            }
                }
            }
        }
        __syncthreads();
        { int td = tid; asm volatile("" : "+v"(td)); hist[td] = 0u; }
        __syncthreads();
        {
            int td = tid; asm volatile("" : "+v"(td));
            unsigned mykey[8];
#pragma unroll
            for (int q = 0; q < 8; ++q) { const int pid = td + 512 * q; const unsigned e = (unsigned)idxs[pid]; mykey[q] = (e << 12) | (unsigned)pid; (void)__hip_atomic_fetch_add(hist + (e >> 6), 1u, __ATOMIC_RELAXED, __HIP_MEMORY_SCOPE_WORKGROUP); }
            __syncthreads();
            if (w == 0) {
                int lane_s = lane; asm volatile("" : "+v"(lane_s));
                unsigned c[4]; unsigned s4 = 0u;
#pragma unroll
                for (int k = 0; k < 4; ++k) { c[k] = hist[4 * lane_s + k]; s4 += c[k]; }
                unsigned inc = s4;
#pragma unroll
                for (int o = 1; o < 64; o <<= 1) { const unsigned up = __shfl_up(inc, o); inc += lane_s >= o ? up : 0u; }
                unsigned ex = inc - s4;
#pragma unroll
                for (int k = 0; k < 4; ++k) { hist[256 + 4 * lane_s + k] = ex; ex += c[k]; }
            }
            __syncthreads();
#pragma unroll
            for (int q = 0; q < 8; ++q) { const unsigned pos = __hip_atomic_fetch_add(hist + 256 + (mykey[q] >> 18), 1u, __ATOMIC_RELAXED, __HIP_MEMORY_SCOPE_WORKGROUP); keys[(pos & 7u) * 512u + (pos >> 3)] = mykey[q]; }
            __syncthreads();
        }
        {
            int ln = lane; asm volatile("" : "+v"(ln));
            const int c16 = (ln & 15) * 16;
            const LAS unsigned* kw = keys + w * 512 + (ln >> 4);
            const unsigned char* ubase = Ub + c16;
#define CO_KEYS(kv, b_) do { kv[0] = kw[(b_) * 8]; kv[1] = kw[(b_) * 8 + 4]; } while (0)
#define CO_LOAD(buf, kreg, kv) do { _Pragma("unroll") for (int s_ = 0; s_ < 2; ++s_) { const unsigned key = kv[s_]; kreg[s_] = key; \
        const unsigned char* ur = ((PROBE_UC && rep_ == 0) ? Vb + c16 : ubase) + (size_t)((PROBE_UF && rep_ == 0) ? (key >> 24) : (key >> 12)) * EROW; \
        _Pragma("unroll") for (int i = 0; i < 4; ++i) buf[s_][i] = *(const u32x4*)(ur + 256 * i); } } while (0)
#define CO_COMP(buf, kreg) do { _Pragma("unroll") for (int s_ = 0; s_ < 2; ++s_) { \
        const unsigned key = kreg[s_]; const int tok = (int)((key >> 7) & 31u), pid = (int)(key & 4095u); u32x4 xh_[4], xl_[4]; \
        _Pragma("unroll") for (int i = 0; i < 4; ++i) { xh_[i] = *(const LAS u32x4*)(xql + tok * 2048 + c16 + 256 * i); xl_[i] = *(const LAS u32x4*)(xql + tok * 2048 + 1024 + c16 + 256 * i); } \
        const float t_g = gts[pid], t_s = sus[pid], t_x = sxl[tok], t_o = sxl[32 + tok]; \
        __builtin_amdgcn_sched_barrier(0); \
        int di = 0, dl_ = 0; \
        _Pragma("unroll") for (int i = 0; i < 4; ++i) _Pragma("unroll") for (int k = 0; k < 4; ++k) { const int w_ = (int)buf[s_][i][k]; di = __builtin_amdgcn_sdot8(w_, (int)xh_[i][k], di, false); dl_ = __builtin_amdgcn_sdot8(w_, (int)xl_[i][k], dl_, false); }     \
        const float ev = row_sum16((float)(di * 16 + dl_)); \
        if ((ln & 15) == 0) { const float act_ = t_g * gelu_tanh((ev + t_o) * (t_s * t_x)); if (PROBE_U && rep_ == 0) ((LAS float*)(lds + SXO + 256))[pid & 511] = act_; else sus[pid] = act_; } \
        if (s_ == 0) asm volatile("" : "+v"(buf[1][0]), "+v"(buf[1][1]), "+v"(buf[1][2]), "+v"(buf[1][3])); } \
        __builtin_amdgcn_sched_barrier(0); } while (0)
            if (!(TSKIP & 1)) for (int rep_ = 0; rep_ < (PROBE_U ? 2 : 1); ++rep_) {
            u32x4 A[2][4], B[2][4]; unsigned kvA[2], kvB[2], kA[2], kB[2];
            CO_KEYS(kvA, 0); CO_KEYS(kvB, 1);
            CO_LOAD(A, kA, kvA); CO_KEYS(kvA, 2);
            for (int b = 0; b < 62; b += 2) {
                if (align_cnt && (b & 15) == 0) xcd_align(align_cnt + (b >> 3) * 64, nloc, w, lane);
                CO_LOAD(B, kB, kvB); CO_KEYS(kvB, b + 3); __builtin_amdgcn_sched_barrier(0);
                CO_COMP(A, kA);
                CO_LOAD(A, kA, kvA); CO_KEYS(kvA, (b + 4) & 63); __builtin_amdgcn_sched_barrier(0);
                CO_COMP(B, kB);
            }
            CO_LOAD(B, kB, kvB); __builtin_amdgcn_sched_barrier(0);
            CO_COMP(A, kA); __builtin_amdgcn_sched_barrier(0);
            CO_COMP(B, kB);
            }
#undef CO_KEYS
#undef CO_LOAD
#undef CO_COMP
        }
        __syncthreads();
        LAS unsigned* keysv = (LAS unsigned*)(lds + XQO); LAS unsigned* wsv = (LAS unsigned*)(lds + XQO + 16384);
        if (!(TSKIP & 32)) for (int s4 = 0; s4 < 4; ++s4) {
            int ln = lane; asm volatile("" : "+v"(ln));
            unsigned kq[2]; int pos[2];
#pragma unroll
            for (int q = 0; q < 2; ++q) { const int pid = (w + 8 * s4) * 128 + ln + 64 * q; kq[q] = ((unsigned)idxs[pid] << 12) | (unsigned)pid; pos[q] = 0; }
            int prefix = 0;
            for (int k = 0; k < 16; ++k) {
                int base = prefix;
#pragma unroll
                for (int q = 0; q < 2; ++q) { const bool hit = (int)(kq[q] >> 22) == k; const unsigned long long m = __ballot(hit);
                    const int r = (int)__builtin_amdgcn_mbcnt_hi((unsigned)(m >> 32), __builtin_amdgcn_mbcnt_lo((unsigned)m, 0u)); pos[q] = hit ? base + r : pos[q]; base += __popcll(m); }
                prefix = base;
            }
#pragma unroll
            for (int q = 0; q < 2; ++q) { const _Float16 wh_ = (_Float16)sus[kq[q] & 4095u]; const h16x2 w2_ = (h16x2){wh_, wh_};
                keysv[512 * w + 128 * s4 + pos[q]] = (kq[q] >> 12) << 10; wsv[512 * w + 128 * s4 + pos[q]] = __builtin_bit_cast(unsigned, w2_); }
        }
        LDS_WAIT(); asm volatile("" ::: "memory");
        for (int pr = 0; pr < 2; ++pr) {
            int ln = lane; asm volatile("" : "+v"(ln));
            h16x2 out[2][16];
#pragma unroll
            for (int sl = 0; sl < 2; ++sl)
#pragma unroll
                for (int i = 0; i < 16; ++i) out[sl][i] = (h16x2){(_Float16)0.f, (_Float16)0.f};
            const LAS unsigned* ka = keysv + 512 * w + 256 * pr; const LAS unsigned* wa = wsv + 512 * w + 256 * pr;
            const __amdgpu_buffer_rsrc_t vrs = __builtin_amdgcn_make_buffer_rsrc((void*)Vb, 0, NEXP * EROW, 0x00020000);
            u32x2 hres[2][8];
#pragma unroll
            for (int sl = 0; sl < 2; ++sl)
#pragma unroll
                for (int m = 0; m < 8; ++m) hres[sl][m] = *(const u32x2*)(Hin + ((size_t)t0 + w + 8 * (2 * pr + sl)) * DM + 256 * m + 4 * ln);
#define PV_KEYS(kv, b_) do { kv[0] = *(const LAS u32x4*)(ka + (b_) * 4); kv[1] = *(const LAS u32x4*)(ka + 128 + (b_) * 4); kv[2] = *(const LAS u32x4*)(wa + (b_) * 4); kv[3] = *(const LAS u32x4*)(wa + 128 + (b_) * 4); } while (0)
#define PV_LOAD(buf, wv, kv) do { _Pragma("unroll") for (int rr = 0; rr < 8; ++rr) { const int off_ = __builtin_amdgcn_readfirstlane((int)kv[rr >> 2][rr & 3]); \
        buf[rr] = __builtin_bit_cast(u32x4, __builtin_amdgcn_raw_buffer_load_b128(vrs, 16 * ln, off_, 0)); } wv[0] = kv[2]; wv[1] = kv[3]; } while (0)
#define PEER_ACC(buf_, sl_, wgt_) do { const h16x2 w2 = __builtin_bit_cast(h16x2, (unsigned)(wgt_)); _Pragma("unroll") for (int i = 0; i < 4; ++i) { \
        out[sl_][4 * i + 0] = __builtin_elementwise_fma(w2, __builtin_bit_cast(h16x2, __builtin_amdgcn_cvt_scalef32_pk_f16_fp4(buf_[i], 1.0f, 0)), out[sl_][4 * i + 0]); out[sl_][4 * i + 1] = __builtin_elementwise_fma(w2, __builtin_bit_cast(h16x2, __builtin_amdgcn_cvt_scalef32_pk_f16_fp4(buf_[i], 1.0f, 1)), out[sl_][4 * i + 1]); \
        out[sl_][4 * i + 2] = __builtin_elementwise_fma(w2, __builtin_bit_cast(h16x2, __builtin_amdgcn_cvt_scalef32_pk_f16_fp4(buf_[i], 1.0f, 2)), out[sl_][4 * i + 2]); out[sl_][4 * i + 3] = __builtin_elementwise_fma(w2, __builtin_bit_cast(h16x2, __builtin_amdgcn_cvt_scalef32_pk_f16_fp4(buf_[i], 1.0f, 3)), out[sl_][4 * i + 3]); } } while (0)
#define PV_COMP(buf, wv) do { _Pragma("unroll") for (int rr = 0; rr < 8; ++rr) { if (rr < 4) PEER_ACC(buf[rr], 0, wv[0][rr & 3]); else PEER_ACC(buf[rr], 1, wv[1][rr & 3]); \
            if (rr < 7) asm volatile("" : "+v"(buf[rr + 1 < 8 ? rr + 1 : 7])); } } while (0)
            if (!(TSKIP & 2)) for (int rep_ = 0; rep_ < (PROBE_V ? 2 : 1); ++rep_) {
                if (PROBE_V && rep_ == 1) {
#pragma unroll
                    for (int sl = 0; sl < 2; ++sl)
#pragma unroll
                        for (int i = 0; i < 16; ++i) { asm volatile("" :: "v"(out[sl][i])); out[sl][i] = (h16x2){(_Float16)0.f, (_Float16)0.f}; }
                }
                u32x4 A[8], B[8], kvA[4], kvB[4], wA[2], wB[2];
                PV_KEYS(kvA, 0); PV_KEYS(kvB, 1);
                PV_LOAD(A, wA, kvA); PV_KEYS(kvA, 2);
                for (int b = 0; b < 30; b += 2) {
                    if (align_cnt && (b & 15) == 0) xcd_align(align_cnt + (8 + pr * 4 + (b >> 3)) * 64, nloc, w, lane);
                    PV_LOAD(B, wB, kvB); PV_KEYS(kvB, b + 3); __builtin_amdgcn_sched_barrier(0);
                    PV_COMP(A, wA);
                    PV_LOAD(A, wA, kvA); PV_KEYS(kvA, (b + 4) & 31); __builtin_amdgcn_sched_barrier(0);
                    PV_COMP(B, wB);
                }
                PV_LOAD(B, wB, kvB); __builtin_amdgcn_sched_barrier(0);
                PV_COMP(A, wA); __builtin_amdgcn_sched_barrier(0);
                PV_COMP(B, wB);
            }
#undef PV_KEYS
#undef PV_LOAD
#undef PEER_ACC
#undef PV_COMP
#pragma unroll
            for (int sl = 0; sl < 2; ++sl) {
                const size_t t = (size_t)t0 + w + 8 * (2 * pr + sl);
                float s2 = 0.f; float of[2][16];
#pragma unroll
                for (int j = 0; j < 2; ++j)
#pragma unroll
                    for (int i = 0; i < 4; ++i) { const u32x2 hb_ = hres[sl][i + 4 * j]; const f32x4 h4 = (f32x4){bf_lo(hb_.x), bf_hi(hb_.x), bf_lo(hb_.y), bf_hi(hb_.y)};
#pragma unroll
                        for (int c = 0; c < 4; ++c) { const float v_ = (float)out[sl][4 * i + c][j] * (1.0f / 256.0f) + h4[c]; of[j][4 * i + c] = v_; s2 += v_ * v_; } }
                s2 = wave_sum(s2);
                if (layer == DEPTH - 1) {
                    const float r2 = rsqrtf(s2 * (1.0f / DM) + EPS);
#pragma unroll
                    for (int j = 0; j < 2; ++j)
#pragma unroll
                        for (int i = 0; i < 4; ++i) { const int e0 = 256 * (i + 4 * j) + 4 * ln; const f32x4 g4 = *(const f32x4*)(a.final_norm + e0); f32x4 o;
#pragma unroll
                            for (int c = 0; c < 4; ++c) o[c] = of[j][4 * i + c] * r2 * g4[c];
                            *(f32x4*)(outp + t * DM + e0) = o; }
                } else {
#pragma unroll
                    for (int j = 0; j < 2; ++j) {
#pragma unroll
                        for (int i = 0; i < 4; ++i) { const int e0 = 256 * (i + 4 * j) + 4 * ln; u32x2 o;
                            o.x = cvtpk(of[j][4 * i], of[j][4 * i + 1]); o.y = cvtpk(of[j][4 * i + 2], of[j][4 * i + 3]);
                            *(u32x2*)(Hb + t * DM + e0) = o; }
                    }
                    if (ln < 32) ssqo[t * 32 + ln] = ln == 0 ? s2 : 0.f;
                }
            }
        }
    }
}
}

constexpr int CW_BAR = 4096, CW_ALIGN = 32768;
static_assert((CW_ALIGN + DEPTH * 16 * 16 * 64) * 4 <= (int)CTL_ZERO_BYTES, "CTL words inside the memset region");
constexpr int N_PHASES = 2 + 8 * DEPTH;

__global__ void __launch_bounds__(512, 2) mk_fwd(Args args) {
    extern __shared__ __attribute__((aligned(16))) unsigned char lds_raw[];
    Frame F;
    F.lds = (LAS unsigned char*)lds_raw;
    F.tid = threadIdx.x; F.lane = F.tid & 63; F.wave = __builtin_amdgcn_readfirstlane(F.tid >> 6);
    F.G = gridDim.x; { const int bx = blockIdx.x; F.vcu = (F.G % 8 == 0) ? (bx % 8) * (F.G / 8) + bx / 8 : bx; }
    volatile LAS unsigned* MISC = (volatile LAS unsigned*)(F.lds + MISC_OFF);
    if (F.tid < 32) MISC[F.tid] = 0u;
    __syncthreads();
    XcdBarrier bar; bar.bar = (unsigned*)(args.ws + WS_CTL) + CW_BAR; bar.x = 0; bar.st = nullptr;
    if (MK_N_LAUNCHES == 1) bar = xcd_barrier_post((unsigned*)(args.ws + WS_CTL) + CW_BAR, MISC + 8);
    const int lo = args.ph_lo, hi = args.ph_hi;
#ifndef EN_MASK
#define EN_MASK 0xFFFF
#endif
#define EN(b) ((EN_MASK >> (b)) & 1)
#define PROBE(b) ((PROBE_MASK >> (b)) & 1)
#ifndef PROBE_SKIP
#define PROBE_SKIP 0
#endif
#define IN(k) (lo <= (k) && (k) < hi)
#define SEAM(k) do { if ((k) + 1 < hi) xcd_barrier(bar, F.wave); } while (0)

#define PH_BEGIN Frame P = F; { const int l_ = fresh_lane(); P.lane = l_; P.tid = F.wave * 64 + l_; } const __attribute__((address_space(4))) Args* kp_ = (const __attribute__((address_space(4))) Args*)__builtin_amdgcn_kernarg_segment_ptr(); asm volatile("" : "+s"(kp_)); const Args a = *(const Args*)kp_; \
    unsigned char* ws = a.ws; \
    float* H = (float*)(ws + WS_H); bf16_t* Hb = (bf16_t*)(ws + WS_HB); float* ssq = (float*)(ws + WS_SSQ); const LAS float* rs = (const LAS float*)(F.lds + RS_OFF); (void)H; (void)Hb; (void)ssq; (void)rs

    if (EN(0) && IN(0)) { PH_BEGIN; if (PROBE(0)) { p0_prologue(P, a); __syncthreads(); } p0_prologue(P, a); SEAM(0); }
    if (EN(1) && IN(1)) { PH_BEGIN;
        pg8::FoldOrder S{(const char*)(ws + WS_KEYSPAD), (const char*)(ws + WS_WQN), F.G, (int)blockIdx.x};
        pg8::EpiBf16 E{(bf16_t*)(ws + WS_WPT), DM};
        pg8::gemm_phase<256, DM, 256>(F.lds, P.tid, S, E);
    }
    for (int L = 0; L < DEPTH; ++L) {
        const int pb = 2 + 8 * L, j = L >> 1;

        if ((L & 1) == 0) {
            if (EN(2) && IN(pb + 0)) { PH_BEGIN;
                pg8::PlainOrder S; S.init(Hb, DM, (bf16_t*)(ws + WS_WCIN) + (size_t)j * NCIN * DM, DM, T, NCIN, F.G, (int)blockIdx.x);
                fill_rstd(P, S, ssq);
                pg8::EpiConvIn E{(bf16_t*)(ws + WS_BG), (bf16_t*)(ws + WS_Z), rs};
                if (PROBE(2)) { pg8::gemm_phase<DM, DM, DM>(F.lds, P.tid, S, E); __syncthreads(); }
                pg8::gemm_phase<DM, DM, DM>(F.lds, P.tid, S, E);
                SEAM(pb + 0);
            }
            if (EN(3) && IN(pb + 1)) { PH_BEGIN; if (PROBE(3)) { conv_gate_phase(P, (const bf16_t*)(ws + WS_BG), (const bf16_t*)(ws + WS_Z), a.conv_kernel + (size_t)j * 3 * DM, (bf16_t*)(ws + WS_Y)); __syncthreads(); } conv_gate_phase(P, (const bf16_t*)(ws + WS_BG), (const bf16_t*)(ws + WS_Z), a.conv_kernel + (size_t)j * 3 * DM, (bf16_t*)(ws + WS_Y)); SEAM(pb + 1); }
            if (EN(4) && IN(pb + 4)) { PH_BEGIN;
                pg8::PlainOrder S; S.init((bf16_t*)(ws + WS_Y), DM, (bf16_t*)(ws + WS_WCOUT) + (size_t)j * DM * DM, DM, T, DM, F.G, (int)blockIdx.x);
                pg8::EpiResid E{L == 0 ? a.x : nullptr, Hb, ssq};
                pg8::gemm_phase<DM, DM, DM>(F.lds, P.tid, S, E);
                SEAM(pb + 4);
            }
        } else {
            if (EN(5) && IN(pb + 0)) { PH_BEGIN;
                pg8::PlainOrder S; S.init(Hb, DM, (bf16_t*)(ws + WS_WNIN) + (size_t)j * NNPAD * DM, DM, T, NNPAD, F.G, (int)blockIdx.x);
                fill_rstd(P, S, ssq);
                pg8::EpiNsaIn E{(bf16_t*)(ws + WS_BG), (bf16_t*)(ws + WS_KV), (float*)(ws + WS_GATES), rs};
                if (PROBE(5)) { pg8::gemm_phase<DM, DM, DM>(F.lds, P.tid, S, E); __syncthreads(); }
                const int nbusy = ((T / 256) * (NNPAD / 256)) % F.G, lay = L == 1 ? 2 : 3;
                if (nbusy == 0) convert_expert_rows(a, ws, P.lane, lay * NEXP, lay * NEXP + CONV_SPLIT, (int)blockIdx.x * 8 + F.wave, F.G * 8, 1);
                pg8::gemm_phase<DM, DM, DM>(F.lds, P.tid, S, E);
                if (nbusy != 0 && (int)blockIdx.x >= nbusy) convert_expert_rows(a, ws, P.lane, lay * NEXP, lay * NEXP + CONV_SPLIT, ((int)blockIdx.x - nbusy) * 8 + F.wave, (F.G - nbusy) * 8, 1);
                SEAM(pb + 0);
            }
            if (EN(6) && IN(pb + 1)) { PH_BEGIN;
                pg8::CmpOrder S{(const char*)(ws + WS_KV), (const char*)((bf16_t*)(ws + WS_WC1) + (size_t)j * 2 * 256 * 4096), F.G, (int)blockIdx.x};
                pg8::EpiSlab E{(bf16_t*)(ws + WS_SLAB)};
                if (PROBE(6)) { pg8::gemm_phase<2048, 4096, 512>(F.lds, P.tid, S, E); __syncthreads(); }
                pg8::gemm_phase<2048, 4096, 512>(F.lds, P.tid, S, E);
                { const int lay2 = L == 1 ? 2 : 3;
                  if (F.G > 128) { if ((int)blockIdx.x >= 128) convert_expert_rows(a, ws, P.lane, lay2 * NEXP + CONV_SPLIT, (lay2 + 1) * NEXP, ((int)blockIdx.x - 128) * 8 + F.wave, (F.G - 128) * 8, 1); }
                  else convert_expert_rows(a, ws, P.lane, lay2 * NEXP + CONV_SPLIT, (lay2 + 1) * NEXP, (int)blockIdx.x * 8 + F.wave, F.G * 8, 1); }
                SEAM(pb + 1);
            }
            if (EN(7) && IN(pb + 2)) { PH_BEGIN;
                if (PROBE(7)) { cmp_finalize_phase(P, (const bf16_t*)(ws + WS_SLAB), (const float*)(ws + WS_BIAS1P) + (size_t)j * 2 * 64 * 256, a.cmp_w2_k + (size_t)j * 256 * 128, a.cmp_w2_v + (size_t)j * 256 * 128,
                                   (bf16_t*)(ws + WS_KC), (bf16_t*)(ws + WS_VC)); __syncthreads(); }
                cmp_finalize_phase(P, (const bf16_t*)(ws + WS_SLAB), (const float*)(ws + WS_BIAS1P) + (size_t)j * 2 * 64 * 256, a.cmp_w2_k + (size_t)j * 256 * 128, a.cmp_w2_v + (size_t)j * 256 * 128,
                                   (bf16_t*)(ws + WS_KC), (bf16_t*)(ws + WS_VC));
                SEAM(pb + 2);
            }
            if (EN(8) && IN(pb + 3)) { PH_BEGIN;
                if (PROBE(8)) { att::attn_phase<PROBE_SKIP>(P, (const bf16_t*)(ws + WS_BG), (const bf16_t*)(ws + WS_KV), (const bf16_t*)(ws + WS_KC), (const bf16_t*)(ws + WS_VC), (const float*)(ws + WS_GATES), a.rel_bias, (bf16_t*)(ws + WS_O)); __syncthreads(); }
                att::attn_phase<0>(P, (const bf16_t*)(ws + WS_BG), (const bf16_t*)(ws + WS_KV), (const bf16_t*)(ws + WS_KC), (const bf16_t*)(ws + WS_VC), (const float*)(ws + WS_GATES), a.rel_bias, (bf16_t*)(ws + WS_O));
                SEAM(pb + 3);
            }
            if (EN(9) && IN(pb + 4)) { PH_BEGIN;
                pg8::PlainOrder S; S.init((bf16_t*)(ws + WS_O), DM, (bf16_t*)(ws + WS_WNOUT) + (size_t)j * DM * DM, DM, T, DM, F.G, (int)blockIdx.x);
                pg8::EpiResid E{L == 0 ? a.x : nullptr, Hb, ssq};
                pg8::gemm_phase<DM, DM, DM>(F.lds, P.tid, S, E);
                SEAM(pb + 4);
            }
        }
        if (EN(10) && IN(pb + 5)) { PH_BEGIN;
            pg8::PlainOrder S; S.init(Hb, DM, (bf16_t*)(ws + WS_WPT) + (size_t)L * DM * DM, DM, T, DM, F.G, (int)blockIdx.x);
            fill_rstd(P, S, ssq);
            pg8::EpiScores E{(bf16_t*)(ws + WS_SC), rs};
            if (PROBE(10)) { pg8::gemm_phase<DM, DM, DM>(F.lds, P.tid, S, E); __syncthreads(); }
            pg8::gemm_phase<DM, DM, DM>(F.lds, P.tid, S, E);
            SEAM(pb + 5);
        }
        if (EN(11) && IN(pb + 6)) { PH_BEGIN;
            if (PROBE(11)) { peer::tail_phase<PROBE_TSKIP>(P, a, L, (const bf16_t*)(ws + WS_SC), Hb, ssq, (bf16_t*)(ws + WS_O), (float*)(ws + WS_BG), (float*)(ws + WS_SLAB), ws + WS_UB + (size_t)L * NEXP * EROW, ws + WS_VB + (size_t)L * NEXP * EROW, (const float*)(ws + WS_USC) + (size_t)L * NEXP, (const float*)(ws + WS_VSC) + (size_t)L * NEXP, nullptr, 1u); __syncthreads(); }
            peer::tail_phase<0>(P, a, L, (const bf16_t*)(ws + WS_SC), Hb, ssq, Hb, ssq, a.out, ws + WS_UB + (size_t)L * NEXP * EROW, ws + WS_VB + (size_t)L * NEXP * EROW, (const float*)(ws + WS_USC) + (size_t)L * NEXP, (const float*)(ws + WS_VSC) + (size_t)L * NEXP,
                             (MK_N_LAUNCHES == 1 && USE_ALIGN) ? (unsigned*)(ws + WS_CTL) + CW_ALIGN + ((L * 16 + (int)xb_xcc_id()) * 16) * 64 : nullptr, MISC[8]);
            SEAM(pb + 6);
        }
    }
#undef IN
#undef EN
#undef SEAM
#undef PH_BEGIN
}

extern "C" void kernel_launch(void* const* d_in, const int* in_sizes, int n_in, void* d_out, int out_size, void* d_ws, size_t ws_size, hipStream_t stream) {
    static int grid = 0;
    if (grid == 0) {
        if (n_in != 20 || out_size != T * DM || ws_size < WS_END) { fprintf(stderr, "kernel_launch: unexpected shapes (n_in %d out %d ws %zu)\n", n_in, out_size, ws_size); grid = -1; return; }
        int dev = 0, cus = 0, per_cu = 0;
        if (hipGetDevice(&dev) != hipSuccess || hipDeviceGetAttribute(&cus, hipDeviceAttributeMultiprocessorCount, dev) != hipSuccess) { grid = -1; return; }
        if (hipFuncSetAttribute((const void*)mk_fwd, hipFuncAttributeMaxDynamicSharedMemorySize, LDS_BYTES) != hipSuccess) { fprintf(stderr, "kernel_launch: hipFuncSetAttribute failed\n"); grid = -1; return; }
        if (hipOccupancyMaxActiveBlocksPerMultiprocessor(&per_cu, (const void*)mk_fwd, 512, LDS_BYTES) != hipSuccess || per_cu < 1) fprintf(stderr, "kernel_launch: occupancy query reports %d\n", per_cu);
        (void)hipGetLastError();
        grid = cus;
    }
    if (grid < 0) return;
    (void)hipMemsetAsync((char*)d_ws + WS_CTL, 0, CTL_ZERO_BYTES, stream);
    Args a{};
    a.x = (const float*)d_in[0]; a.rel_bias = (const float*)d_in[1]; a.mix_norm = (const float*)d_in[2]; a.ffn_norm = (const float*)d_in[3]; a.final_norm = (const float*)d_in[4];
    a.conv_w_in = (const float*)d_in[5]; a.conv_kernel = (const float*)d_in[6]; a.conv_w_out = (const float*)d_in[7];
    a.nsa_w_in = (const float*)d_in[8]; a.cmp_pos_k = (const float*)d_in[9]; a.cmp_pos_v = (const float*)d_in[10]; a.cmp_w1_k = (const float*)d_in[11]; a.cmp_w2_k = (const float*)d_in[12];
    a.cmp_w1_v = (const float*)d_in[13]; a.cmp_w2_v = (const float*)d_in[14]; a.nsa_w_out = (const float*)d_in[15];
    a.peer_w_q = (const float*)d_in[16]; a.peer_sub_keys = (const float*)d_in[17]; a.peer_u = (const float*)d_in[18]; a.peer_v = (const float*)d_in[19];
    a.out = (float*)d_out; a.ws = (unsigned char*)d_ws;
    if (MK_N_LAUNCHES == 1) {
        a.ph_lo = 0; a.ph_hi = N_PHASES; a.li = 0;
        hipLaunchKernelGGL(mk_fwd, dim3(grid), dim3(512), LDS_BYTES, stream, a);
    } else {
        for (int p = 0; p < N_PHASES; ++p) {
            const int s = p < 2 ? -1 : (p - 2) & 7, L = p < 2 ? 0 : (p - 2) >> 3;
            if (s == 7) continue; if ((L & 1) == 0 && (s == 2 || s == 3)) continue;
            a.ph_lo = p; a.ph_hi = p + 1; a.li = p;
            hipLaunchKernelGGL(mk_fwd, dim3(grid), dim3(512), LDS_BYTES, stream, a);
        }
    }
}
```
